# Optimizing an MI355X kernel written in HIP

```python
import math
import jax, jax.numpy as jnp
from jax import lax
import numpy as np

D_MODEL = 1024
BATCH = 4
SEQ = 8192
DEPTH = 4

D_FF = 2816
EPS = 1e-6
A_HEADS = 8
A_KV_HEADS = 2
A_HEAD_DIM = 64
WINDOW = 128
B_HEADS = 4
B_KEY_DIM = 128
B_VAL_DIM = 128
B_CHUNK = 32
S5_GROUP = 16
S5_GROUPS = D_MODEL // S5_GROUP
S5_STATE = 64
S5_DT_MIN = 1e-3
S5_DT_MAX = 1e-1

A_Q_W = A_HEADS * A_HEAD_DIM
A_KV_W = A_KV_HEADS * A_HEAD_DIM
B_W = B_HEADS * B_KEY_DIM
MIX_SPLITS = (A_Q_W, A_Q_W + A_KV_W, A_Q_W + 2 * A_KV_W, A_Q_W + 2 * A_KV_W + B_W, A_Q_W + 2 * A_KV_W + 2 * B_W, A_Q_W + 2 * A_KV_W + 3 * B_W)
MIX_IN = A_Q_W + 2 * A_KV_W + 4 * B_W
MIX_OUT = A_Q_W + B_HEADS * B_VAL_DIM
N_EVEN = (DEPTH + 1) // 2
N_ODD = DEPTH // 2

kernel_name = 'hybrid_swa_hgrn2_s5_macaron'


def _rmsnorm(x, g):
    x32 = x.astype(jnp.float32)
    y = x32 * lax.rsqrt(jnp.mean(x32 * x32, axis=-1, keepdims=True) + EPS)
    return (y * g.astype(jnp.float32)).astype(x.dtype)


def _swiglu(h, w_in, w_out):
    gate, up = jnp.split(h @ w_in, 2, axis=-1)
    return (jax.nn.silu(gate) * up) @ w_out


def _alibi_slopes():
    s = 2.0 ** (-8.0 * np.arange(1, A_HEADS + 1) / A_HEADS)
    return jnp.asarray(s, dtype=jnp.float32).reshape(A_KV_HEADS, A_HEADS // A_KV_HEADS)


def _sliding_window_gqa(q, k, v, sinks):
    b, l, _ = q.shape
    nb = l // WINDOW
    grp = A_HEADS // A_KV_HEADS
    qb = q.reshape(b, nb, WINDOW, A_KV_HEADS, grp, A_HEAD_DIM)
    kb = k.reshape(b, nb, WINDOW, A_KV_HEADS, A_HEAD_DIM)
    vb = v.reshape(b, nb, WINDOW, A_KV_HEADS, A_HEAD_DIM)
    pad = ((0, 0), (1, 0), (0, 0), (0, 0), (0, 0))
    kw = jnp.concatenate([jnp.pad(kb[:, :-1], pad), kb], axis=2)
    vw = jnp.concatenate([jnp.pad(vb[:, :-1], pad), vb], axis=2)
    s = jnp.einsum('bnqhgd,bnkhd->bnhgqk', qb, kw, preferred_element_type=jnp.float32) * (A_HEAD_DIM ** -0.5)
    qpos = jnp.arange(WINDOW) + WINDOW
    kpos = jnp.arange(2 * WINDOW)
    dist_i = qpos[:, None] - kpos[None, :]
    in_band = (dist_i >= 0) & (dist_i < WINDOW)
    has_prev = (jnp.arange(nb)[:, None, None] > 0) | (kpos[None, None, :] >= WINDOW)
    mask = in_band[None] & has_prev
    dist = dist_i.astype(jnp.float32)
    s = s - _alibi_slopes()[:, :, None, None] * dist
    s = jnp.where(mask[None, :, None, None], s, -jnp.inf)
    sink = sinks.astype(jnp.float32).reshape(A_KV_HEADS, grp)[None, None, :, :, None, None]
    m = jnp.maximum(jnp.max(s, axis=-1, keepdims=True), sink)
    p = jnp.exp(s - m)
    denom = jnp.sum(p, axis=-1, keepdims=True) + jnp.exp(sink - m)
    o = jnp.einsum('bnhgqk,bnkhd->bnhgqd', p / denom, vw.astype(jnp.float32))
    o = o.transpose(0, 1, 4, 2, 3, 5).reshape(b, l, A_Q_W)
    return o.astype(q.dtype)


def _hgrn2(q, f_logit, i_val, g, lb):
    b, l, _ = q.shape
    nc = l // B_CHUNK

    def heads(t):
        return t.astype(jnp.float32).reshape(b, nc, B_CHUNK, B_HEADS, -1).transpose(0, 3, 1, 2, 4)

    lbh = lb.astype(jnp.float32).reshape(B_HEADS, 1, 1, B_KEY_DIM)
    f = lbh + (1.0 - lbh) * jax.nn.sigmoid(heads(f_logit))
    k = 1.0 - f
    qh = jax.nn.silu(heads(q))
    vh = heads(i_val)
    cum = jnp.cumsum(jnp.log(f), axis=3)
    q_dec = qh * jnp.exp(cum)
    k_inv = k * jnp.exp(-cum)
    k_end = k * jnp.exp(cum[:, :, :, -1:] - cum)
    causal = jnp.tril(jnp.ones((B_CHUNK, B_CHUNK), dtype=bool))
    scores = jnp.where(causal, jnp.einsum('bhnqd,bhnkd->bhnqk', q_dec, k_inv), 0.0)
    o = jnp.einsum('bhnqk,bhnkv->bhnqv', scores, vh)
    chunk_decay = jnp.exp(cum[:, :, :, -1])
    chunk_kv = jnp.einsum('bhnkd,bhnkv->bhndv', k_end, vh)

    def step(state, inp):
        dec, kv = inp
        return dec[..., None] * state + kv, state

    s0 = jnp.zeros((b, B_HEADS, B_KEY_DIM, B_VAL_DIM), jnp.float32)
    _, s_start = lax.scan(step, s0, (jnp.moveaxis(chunk_decay, 2, 0), jnp.moveaxis(chunk_kv, 2, 0)))
    o = o + jnp.einsum('bhnqd,nbhdv->bhnqv', q_dec, s_start)
    o = o.transpose(0, 2, 3, 1, 4).reshape(b, l, B_HEADS, B_VAL_DIM)
    o = o * lax.rsqrt(jnp.mean(o * o, axis=-1, keepdims=True) + EPS)
    gate = jax.nn.silu(g.astype(jnp.float32)).reshape(b, l, B_HEADS, B_VAL_DIM)
    return (o * gate).reshape(b, l, B_HEADS * B_VAL_DIM).astype(q.dtype)


def _complex_linear_combine(e1, e2):
    ar1, ai1, br1, bi1 = e1
    ar2, ai2, br2, bi2 = e2
    ar = ar2 * ar1 - ai2 * ai1
    ai = ar2 * ai1 + ai2 * ar1
    br = ar2 * br1 - ai2 * bi1 + br2
    bi = ar2 * bi1 + ai2 * br1 + bi2
    return (ar, ai, br, bi)


def _s5(u, a_re, a_im, log_step, b_re, b_im, c_re, c_im, d_skip):
    b, l, _ = u.shape
    u32 = u.astype(jnp.float32)
    lam_r = a_re.astype(jnp.float32)
    lam_i = a_im.astype(jnp.float32)
    step = jnp.exp(log_step.astype(jnp.float32))[:, None]
    mag = jnp.exp(step * lam_r)
    ab_r = mag * jnp.cos(step * lam_i)
    ab_i = mag * jnp.sin(step * lam_i)
    den = lam_r * lam_r + lam_i * lam_i
    coef_r = ((ab_r - 1.0) * lam_r + ab_i * lam_i) / den
    coef_i = (ab_i * lam_r - (ab_r - 1.0) * lam_i) / den
    br = b_re.astype(jnp.float32)
    bi = b_im.astype(jnp.float32)
    bb_r = coef_r[..., None] * br - coef_i[..., None] * bi
    bb_i = coef_r[..., None] * bi + coef_i[..., None] * br
    ug = u32.reshape(b, l, S5_GROUPS, S5_GROUP)
    bu_r = jnp.einsum('blgc,gpc->blgp', ug, bb_r)
    bu_i = jnp.einsum('blgc,gpc->blgp', ug, bb_i)
    a_shape = (1, l, S5_GROUPS, S5_STATE)
    ar = jnp.broadcast_to(ab_r[None, None], a_shape)
    ai = jnp.broadcast_to(ab_i[None, None], a_shape)
    _, _, xr, xi = lax.associative_scan(_complex_linear_combine, (ar, ai, bu_r, bu_i), axis=1)
    y = jnp.einsum('blgp,gcp->blgc', xr, c_re.astype(jnp.float32)) - jnp.einsum('blgp,gcp->blgc', xi, c_im.astype(jnp.float32))
    return y.reshape(b, l, D_MODEL) + d_skip.astype(jnp.float32) * u32


def setup_inputs(seed: int = 0) -> dict:
    key = jax.random.key(seed)
    ks = jax.random.split(key, 18)
    f32 = jnp.float32

    def nrm(k, shape, scale):
        return jax.random.normal(k, shape, f32) * scale

    n = jnp.arange(S5_STATE, dtype=f32)
    return {
        'x': nrm(ks[0], (BATCH, SEQ, D_MODEL), 1.0),
        'norm_g': 1.0 + nrm(ks[1], (DEPTH, 3, D_MODEL), 0.02),
        'ffn_w_in': nrm(ks[2], (DEPTH, 2, D_MODEL, 2 * D_FF), D_MODEL ** -0.5),
        'ffn_w_out': nrm(ks[3], (DEPTH, 2, D_FF, D_MODEL), D_FF ** -0.5),
        'mix_w_in': nrm(ks[4], (N_EVEN, D_MODEL, MIX_IN), D_MODEL ** -0.5),
        'attn_sinks': nrm(ks[5], (N_EVEN, A_HEADS), 0.5),
        'hgrn_lb': nrm(ks[6], (N_EVEN, B_HEADS * B_KEY_DIM), 0.1),
        'mix_w_out': nrm(ks[7], (N_EVEN, MIX_OUT, D_MODEL), MIX_OUT ** -0.5),
        's5_a_re': -0.5 + nrm(ks[8], (N_ODD, S5_GROUPS, S5_STATE), 0.01),
        's5_a_im': math.pi * n + nrm(ks[9], (N_ODD, S5_GROUPS, S5_STATE), 0.01),
        's5_log_step': jax.random.uniform(ks[10], (N_ODD, S5_GROUPS), f32, math.log(S5_DT_MIN), math.log(S5_DT_MAX)),
        's5_b_re': nrm(ks[11], (N_ODD, S5_GROUPS, S5_STATE, S5_GROUP), (2 * S5_GROUP) ** -0.5),
        's5_b_im': nrm(ks[12], (N_ODD, S5_GROUPS, S5_STATE, S5_GROUP), (2 * S5_GROUP) ** -0.5),
        's5_c_re': nrm(ks[13], (N_ODD, S5_GROUPS, S5_GROUP, S5_STATE), S5_STATE ** -0.5),
        's5_c_im': nrm(ks[14], (N_ODD, S5_GROUPS, S5_GROUP, S5_STATE), S5_STATE ** -0.5),
        's5_d': nrm(ks[15], (N_ODD, D_MODEL), 1.0),
        's5_w_glu': nrm(ks[16], (N_ODD, D_MODEL, 2 * D_MODEL), D_MODEL ** -0.5),
        'final_g': 1.0 + nrm(ks[17], (D_MODEL,), 0.02),
    }


def reference(x, norm_g, ffn_w_in, ffn_w_out, mix_w_in, attn_sinks, hgrn_lb, mix_w_out, s5_a_re, s5_a_im, s5_log_step, s5_b_re, s5_b_im, s5_c_re, s5_c_im, s5_d, s5_w_glu, final_g):
    lb_p = jax.nn.softmax(hgrn_lb.astype(jnp.float32), axis=0)
    lb_all = jnp.cumsum(lb_p, axis=0) - lb_p[0]
    for layer in range(DEPTH):
        x = x + 0.5 * _swiglu(_rmsnorm(x, norm_g[layer, 0]), ffn_w_in[layer, 0], ffn_w_out[layer, 0])
        h = _rmsnorm(x, norm_g[layer, 1])
        if layer % 2 == 0:
            e = layer // 2
            q_a, k_a, v_a, q_b, f_b, i_b, g_b = jnp.split(h @ mix_w_in[e], MIX_SPLITS, axis=-1)
            attn = _sliding_window_gqa(q_a, k_a, v_a, attn_sinks[e])
            rec = _hgrn2(q_b, f_b, i_b, g_b, lb_all[e])
            mix = jnp.concatenate([attn, rec], axis=-1) @ mix_w_out[e]
        else:
            o = layer // 2
            y = _s5(h, s5_a_re[o], s5_a_im[o], s5_log_step[o], s5_b_re[o], s5_b_im[o], s5_c_re[o], s5_c_im[o], s5_d[o])
            y = jax.nn.gelu(y).astype(x.dtype)
            val, gate = jnp.split(y @ s5_w_glu[o], 2, axis=-1)
            mix = val * jax.nn.sigmoid(gate)
        x = x + mix.astype(x.dtype)
        x = x + 0.5 * _swiglu(_rmsnorm(x, norm_g[layer, 2]), ffn_w_in[layer, 1], ffn_w_out[layer, 1])
    return _rmsnorm(x, final_g)
```

```cpp
#include <hip/hip_runtime.h>
#include <hip/hip_cooperative_groups.h>
#include <cstdio>
#include <cstdint>
namespace cg = cooperative_groups;

#define LAS __attribute__((address_space(3)))
typedef unsigned short bf16_t;
typedef short bf16x8 __attribute__((ext_vector_type(8)));
typedef float f32x4 __attribute__((ext_vector_type(4)));
typedef float f32x2 __attribute__((ext_vector_type(2)));
typedef unsigned u32x4 __attribute__((ext_vector_type(4)));
typedef unsigned u32x2 __attribute__((ext_vector_type(2)));

constexpr int BATCH = 4, SEQ = 8192, DM = 1024, DEPTH = 4, DFF = 2816;
constexpr int M = BATCH * SEQ;
constexpr int MIXIN = 2816;
constexpr float EPS = 1e-6f;
constexpr int NWAVES = 8;

constexpr size_t SZ_WFFN_IN = (size_t)2 * DFF * DM * 2;
constexpr size_t SZ_WFFN_OUT = (size_t)DM * DFF * 2;
constexpr size_t SZ_WMIX_IN = (size_t)MIXIN * DM * 2;
constexpr size_t SZ_WMIX_OUT = (size_t)DM * DM * 2;
constexpr size_t SZ_WGLU = (size_t)2 * DM * DM * 2;
constexpr size_t WS_WFFN_IN = 0;
constexpr size_t WS_WFFN_OUT = WS_WFFN_IN + 8 * SZ_WFFN_IN;
constexpr size_t WS_WMIX_IN = WS_WFFN_OUT + 8 * SZ_WFFN_OUT;
constexpr size_t WS_WMIX_OUT = WS_WMIX_IN + 2 * SZ_WMIX_IN;
constexpr size_t WS_WGLU = WS_WMIX_OUT + 2 * SZ_WMIX_OUT;
constexpr size_t WS_XB = WS_WGLU + 2 * SZ_WGLU;
constexpr size_t WS_ACT = WS_XB + (size_t)M * DM * 2;
constexpr size_t WS_CAT = WS_ACT + (size_t)M * DFF * 2;
constexpr size_t WS_SSQ = WS_CAT + (size_t)M * DM * 2;
constexpr size_t WS_F = WS_SSQ + (size_t)M * 32 * 4;
constexpr size_t WS_QS = WS_F + (size_t)M * 512 * 4;
constexpr size_t WS_OB = WS_QS + (size_t)M * 512 * 4;
constexpr int HNS = 16, HSEG = SEQ / HNS;
constexpr size_t WS_HS = WS_OB + (size_t)M * 512 * 4;
constexpr size_t WS_HD = WS_HS + (size_t)256 * 512 * 32 * 4;
constexpr size_t WS_CTL = WS_HD + (size_t)256 * 512 * 8 * 4;
constexpr size_t CTL_BYTES = 16384;
constexpr size_t WS_END = WS_CTL + CTL_BYTES;

constexpr int RING_BYTES = 131072;
constexpr int TBL_OFF = RING_BYTES;
constexpr int MISC_OFF = RING_BYTES + 12288;
constexpr int LDS_BYTES = 147456;

__device__ __forceinline__ int otid() { int t = threadIdx.x; asm volatile("" : "+v"(t)); return t; }
__device__ __forceinline__ int obid() { int b = blockIdx.x; asm volatile("" : "+s"(b)); return b; }
template <class T> __device__ __forceinline__ T* optr(T* p) { asm volatile("" : "+s"(p)); return p; }
typedef __bf16 bf16x2_t __attribute__((ext_vector_type(2)));
__device__ __forceinline__ unsigned cvt_pk_bf16(float lo, float hi) { const f32x2 v = {lo, hi}; const bf16x2_t b = __builtin_convertvector(v, bf16x2_t); return __builtin_bit_cast(unsigned, b); }
__device__ __forceinline__ float bf2f(unsigned short h) { return __uint_as_float(((unsigned)h) << 16); }
__device__ __forceinline__ float bflo(unsigned w) { return __uint_as_float(w << 16); }
__device__ __forceinline__ float bfhi(unsigned w) { return __uint_as_float(w & 0xffff0000u); }
__device__ __forceinline__ float fast_rcp(float x) { return __builtin_amdgcn_rcpf(x); }
__device__ __forceinline__ float sigmoidf_(float x) { return fast_rcp(1.f + __expf(-x)); }
__device__ __forceinline__ float siluf_(float x) { return x * sigmoidf_(x); }
__device__ __forceinline__ float wave_sum(float v) {
#pragma unroll
    for (int o = 1; o < 64; o <<= 1) v += __shfl_xor(v, o);
    return v;
}
__device__ __forceinline__ float gelu_tanh(float v) {
    const float u = 0.7978845608028654f * (v + 0.044715f * v * v * v);
    const float t = 1.f - 2.f * fast_rcp(1.f + __expf(2.f * u));
    return 0.5f * v * (1.f + t);
}

struct RsRegs { f32x4 v[4]; };
namespace pg8 {
constexpr int BM = 256, BK = 64, HALF = 128, HTB = HALF * BK * 2, STAGE_BYTES = 8 * HTB, NXCD = 8, WGM = 8;
__device__ __forceinline__ int lds_byte(int r, int c) { const int st = (r >> 4) * 2 + (c >> 5), rr = r & 15, cc = c & 31, ob = rr * 64 + cc * 2; return st * 1024 + (ob ^ (((ob >> 9) & 1) << 5)); }
__device__ __forceinline__ void stage_rc(int b, int& R, int& C) { const int st = b / 1024, sb = b % 1024, swz = sb ^ (((sb >> 9) & 1) << 5); R = (st >> 1) * 16 + swz / 64; C = (st & 1) * 32 + (swz % 64) / 2; }
__device__ __forceinline__ int perm32(int rho) { const int n = rho >> 4, i = rho & 15; return 8 * (i >> 2) + 4 * n + (i & 3); }

struct Unit { int pm, pn; };
struct Gemm { const bf16_t* A; const bf16_t* Bt; int M, N, K; };

struct StaticOrder {
    int nM, nN, nwg, G, c;
    __device__ void init(int M_, int N_, int G_, int c_) { nM = M_ / BM; nN = N_ / BM; nwg = nM * nN; G = G_; c = c_; }
    __device__ bool next(int i, Unit& u) const {
        const long L = (long)i * G + c; if (L >= nwg) return false;
        int wgid = (int)L; { const int q = nwg / NXCD, r = nwg % NXCD, xcd = wgid % NXCD, off = wgid / NXCD; wgid = (xcd < r ? xcd * (q + 1) : r * (q + 1) + (xcd - r) * q) + off; }
        const int nig = WGM * nN, gid = wgid / nig, fm = gid * WGM, gsz = (nM - fm) < WGM ? (nM - fm) : WGM;
        u.pm = fm + ((wgid % nig) % gsz); u.pn = (wgid % nig) / gsz; return true;
    }
};

template <class Epi>
__device__ __forceinline__ void gemm_phase(LAS unsigned char* lds, const Gemm g, const StaticOrder& S, const Epi& E) {
    const int tid = otid(), wid = __builtin_amdgcn_readfirstlane(tid >> 6), lane = tid & 63, wr = wid >> 2, wc = wid & 3, fr = lane & 15, fq = lane >> 4;
    const int K = g.K, nt = K / BK;
    const char* gA = (const char*)optr(g.A); const char* gB = (const char*)optr(g.Bt);
    unsigned voffA[2], voffB[2];
#pragma unroll
    for (int i = 0; i < 2; ++i) { int R, C; stage_rc(tid * 16 + i * 8192, R, C); const int Rb = Epi::PERM ? ((R & ~31) + perm32(R & 31)) : R;
        voffA[i] = (unsigned)(R * K + C) * 2u; voffB[i] = (unsigned)(Rb * K + C) * 2u; }
    const size_t kstep = (size_t)(BK * 2);
    const size_t hstep = (size_t)HALF * K * 2;
    const size_t tstep = 2 * hstep;
    const unsigned ldsw = (unsigned)wid * 1024u;
    const int aoff = lds_byte(wr * 64 + fr, fq * 8), boff = lds_byte(wc * 32 + fr, fq * 8);
#define PG8_SA(b, h) (((b) * 2 + (h)) * HTB)
#define PG8_SB(b, h) ((4 + (b) * 2 + (h)) * HTB)
#define PG8_STAGE(bufoff, gbase, voff) do { _Pragma("unroll") for (int _i = 0; _i < 2; ++_i) \
        __builtin_amdgcn_global_load_lds((const unsigned*)((const char*)(gbase) + (voff)[_i]), (LAS unsigned*)(lds + (bufoff) + ldsw + _i * 8192), 16, 0, 0); } while (0)
#define PG8_LDA(dst, b, h) do { _Pragma("unroll") for (int m = 0; m < 4; ++m) _Pragma("unroll") for (int k = 0; k < 2; ++k) dst[m][k] = *(const LAS bf16x8*)(lds + PG8_SA(b, h) + aoff + m * 2048 + k * 1024); } while (0)
#define PG8_LDB(dst, b, h) do { _Pragma("unroll") for (int n = 0; n < 2; ++n) _Pragma("unroll") for (int k = 0; k < 2; ++k) dst[n][k] = *(const LAS bf16x8*)(lds + PG8_SB(b, h) + boff + n * 2048 + k * 1024); } while (0)
#define PG8_MMA(ai, bj, At, Bt) do { __builtin_amdgcn_s_setprio(1); _Pragma("unroll") for (int m = 0; m < 4; ++m) _Pragma("unroll") for (int n = 0; n < 2; ++n) _Pragma("unroll") for (int k = 0; k < 2; ++k) \
        acc[ai][bj][m][n] = __builtin_amdgcn_mfma_f32_16x16x32_bf16(Bt[n][k], At[m][k], acc[ai][bj][m][n], 0, 0, 0); __builtin_amdgcn_s_setprio(0); } while (0)
#define PG8_WAIT_V(n) asm volatile("s_waitcnt vmcnt(" #n ")" ::: "memory")
#define PG8_WAIT_L(n) asm volatile("s_waitcnt lgkmcnt(" #n ")" ::: "memory")
#define PG8_BAR __builtin_amdgcn_s_barrier()
#define PG8_SCHED __builtin_amdgcn_sched_barrier(0)
    Unit cur, nxt; int ui = 0;
    if (!S.next(0, cur)) return;
    f32x4 acc[2][2][4][2];
#pragma unroll
    for (int a = 0; a < 2; ++a)
#pragma unroll
        for (int b = 0; b < 2; ++b)
#pragma unroll
            for (int m = 0; m < 4; ++m)
#pragma unroll
                for (int n = 0; n < 2; ++n) acc[a][b][m][n] = (f32x4){0.f, 0.f, 0.f, 0.f};
    bf16x8 At[4][2], B0[2][2], B1[2][2];
    const char* cA = gA + (size_t)cur.pm * tstep; const char* cB = gB + (size_t)cur.pn * tstep;
    RsRegs rsr; E.issue(cur, rsr); E.commit(0, rsr);
    int tsel = 0;
    PG8_STAGE(PG8_SB(0, 0), cB, voffB); PG8_STAGE(PG8_SB(0, 1), cB + hstep, voffB); PG8_STAGE(PG8_SA(0, 0), cA, voffA); PG8_STAGE(PG8_SA(0, 1), cA + hstep, voffA);
    if (wr == 1) PG8_BAR;
    PG8_WAIT_V(2); PG8_BAR;
    PG8_STAGE(PG8_SB(1, 0), cB + kstep, voffB); PG8_STAGE(PG8_SA(1, 0), cA + kstep, voffA); PG8_STAGE(PG8_SB(1, 1), cB + hstep + kstep, voffB);
    PG8_WAIT_V(6); PG8_BAR;
    for (;;) {
        const bool has_next = S.next(ui + 1, nxt);
        const char* nA = has_next ? gA + (size_t)nxt.pm * tstep : cA; const char* nB = has_next ? gB + (size_t)nxt.pn * tstep : cB;
        for (int t = 0; t < nt; t += 2) {
            const bool last = (t == nt - 2);
            const char* a1 = cA + (size_t)(t + 1) * kstep;
            const char* a2 = last ? nA : cA + (size_t)(t + 2) * kstep; const char* b2 = last ? nB : cB + (size_t)(t + 2) * kstep;
            const char* a3 = a2 + kstep; const char* b3 = b2 + kstep;
            const int strict = __builtin_amdgcn_readfirstlane(((t == 0) && (ui > 0)) ? 0 : 1);
#define PG8_WAIT_V8R asm volatile("s_waitcnt vmcnt(%1)\n\ts_cmp_eq_u32 %0, 0\n\ts_cbranch_scc1 1f\n\ts_waitcnt vmcnt(8)\n1:" :: "s"(strict), "n"(8 + Epi::NVM) : "scc", "memory")
            PG8_LDB(B0, 0, 0); PG8_LDB(B1, 0, 1); PG8_SCHED; PG8_LDA(At, 0, 0); PG8_STAGE(PG8_SA(1, 1), a1 + hstep, voffA);
            PG8_WAIT_V8R;
            PG8_WAIT_L(0); PG8_BAR; PG8_MMA(0, 0, At, B0); PG8_MMA(0, 1, At, B1); PG8_BAR; PG8_SCHED;
            PG8_LDA(At, 0, 1); PG8_STAGE(PG8_SB(0, 0), b2, voffB); PG8_STAGE(PG8_SB(0, 1), b2 + hstep, voffB); PG8_STAGE(PG8_SA(0, 0), a2, voffA);
            PG8_WAIT_V8R;
            PG8_WAIT_L(0); PG8_BAR; PG8_MMA(1, 0, At, B0); PG8_MMA(1, 1, At, B1); PG8_BAR; PG8_SCHED;
            PG8_LDB(B0, 1, 0); PG8_LDB(B1, 1, 1); PG8_SCHED; PG8_LDA(At, 1, 0); PG8_STAGE(PG8_SA(0, 1), a2 + hstep, voffA);
            PG8_WAIT_V(8); PG8_WAIT_L(0); PG8_BAR; PG8_MMA(0, 0, At, B0); PG8_MMA(0, 1, At, B1); PG8_BAR; PG8_SCHED;
            PG8_LDA(At, 1, 1); PG8_STAGE(PG8_SB(1, 0), b3, voffB); PG8_STAGE(PG8_SB(1, 1), b3 + hstep, voffB); PG8_STAGE(PG8_SA(1, 0), a3, voffA);
            PG8_WAIT_V(8); PG8_WAIT_L(0); PG8_BAR; PG8_MMA(1, 0, At, B0); PG8_MMA(1, 1, At, B1); PG8_BAR; PG8_SCHED;
        }
        if (wr == 0) PG8_BAR;
        const bool newpm = has_next && (nxt.pm != cur.pm);
        if (newpm) E.issue(nxt, rsr);
        E(acc, cur, tsel, wr, wc, fr, fq);
        if (!has_next) break;
#pragma unroll
        for (int a = 0; a < 2; ++a)
#pragma unroll
            for (int b = 0; b < 2; ++b)
#pragma unroll
                for (int m = 0; m < 4; ++m)
#pragma unroll
                    for (int n = 0; n < 2; ++n) acc[a][b][m][n] = (f32x4){0.f, 0.f, 0.f, 0.f};
        cur = nxt; cA = nA; cB = nB; ++ui;
        if (newpm) { tsel ^= 1; E.commit(tsel, rsr); }
        if (wr == 1) PG8_BAR;
    }
    PG8_WAIT_V(0);
    PG8_BAR;
#undef PG8_SA
#undef PG8_SB
#undef PG8_STAGE
#undef PG8_LDA
#undef PG8_LDB
#undef PG8_MMA
#undef PG8_WAIT_V
#undef PG8_WAIT_V8R
#undef PG8_WAIT_L
#undef PG8_BAR
#undef PG8_SCHED
}
}
using pg8::Unit;

struct RsTable {
    const float* ssq; int np; LAS float* tbl;
    __device__ __forceinline__ void issue(const Unit& u, RsRegs& R) const {
        const int t = otid(), row = t >> 1, half = t & 1, hn = np >> 1;
        const float* p = ssq + (size_t)(u.pm * 256 + row) * 32 + half * hn;
        R.v[0] = *(const f32x4*)p; R.v[1] = *(const f32x4*)(p + 4);
        if (hn > 8) { R.v[2] = *(const f32x4*)(p + 8); R.v[3] = *(const f32x4*)(p + 12); } else { R.v[2] = (f32x4){0.f, 0.f, 0.f, 0.f}; R.v[3] = R.v[2]; }
    }
    __device__ __forceinline__ void commit(int ui, const RsRegs& R) const {
        const int t = otid(), row = t >> 1, half = t & 1;
        const f32x4 a = (R.v[0] + R.v[1]) + (R.v[2] + R.v[3]);
        float s = (a.x + a.y) + (a.z + a.w);
        s += __shfl_xor(s, 1);
        if (!half) tbl[(ui & 1) * 256 + row] = rsqrtf(s * (1.f / DM) + EPS);
    }
};

struct EpiSwiglu {
    static constexpr bool PERM = true; static constexpr int NVM = 8;
    bf16_t* O; RsTable rt;
    __device__ __forceinline__ void issue(const Unit& u, RsRegs& R) const { rt.issue(u, R); }
    __device__ __forceinline__ void commit(int ui, const RsRegs& R) const { rt.commit(ui, R); }
    __device__ __forceinline__ void operator()(const f32x4 (&acc)[2][2][4][2], const Unit& u, int ui, int wr, int wc, int fr, int fq) const {
        const LAS float* tb = rt.tbl + (ui & 1) * 256;
        const int col0 = u.pn * 128 + wc * 32 + 8 * fq;
#pragma unroll
        for (int ai = 0; ai < 2; ++ai)
#pragma unroll
            for (int m = 0; m < 4; ++m) {
                const int r = ai * 128 + wr * 64 + m * 16 + fr; const float rs = tb[r];
                const float nrl = -1.4426950408889634f * rs, rs2 = rs * rs;
                float o[8];
#pragma unroll
                for (int n = 0; n < 2; ++n)
#pragma unroll
                    for (int j = 0; j < 4; ++j) { const float ag = acc[ai][0][m][n][j], au = acc[ai][1][m][n][j];
                        const float e = __builtin_amdgcn_exp2f(ag * nrl);
                        o[n * 4 + j] = (ag * au) * (fast_rcp(1.f + e) * rs2); }
                u32x4 w; w.x = cvt_pk_bf16(o[0], o[1]); w.y = cvt_pk_bf16(o[2], o[3]); w.z = cvt_pk_bf16(o[4], o[5]); w.w = cvt_pk_bf16(o[6], o[7]);
                *(u32x4*)(O + (size_t)(u.pm * 256 + r) * DFF + col0) = w;
            }
    }
};

struct EpiMixIn {
    static constexpr bool PERM = true; static constexpr int NVM = 16;
    bf16_t* P; float* F; float* QS; const float* lbraw; int e; RsTable rt;
    __device__ __forceinline__ void issue(const Unit& u, RsRegs& R) const { rt.issue(u, R); }
    __device__ __forceinline__ void commit(int ui, const RsRegs& R) const { rt.commit(ui, R); }
    __device__ __forceinline__ void operator()(const f32x4 (&acc)[2][2][4][2], const Unit& u, int ui, int wr, int wc, int fr, int fq) const {
        const LAS float* tb = rt.tbl + (ui & 1) * 256;
        const int mode = (u.pn == 5 || u.pn == 6) ? 1 : ((u.pn == 3 || u.pn == 4) ? 2 : 0);
#pragma unroll
        for (int bj = 0; bj < 2; ++bj) {
            const int col0 = u.pn * 256 + bj * 128 + wc * 32 + 8 * fq;
            float lb[8];
#pragma unroll
            for (int j = 0; j < 8; ++j) lb[j] = 0.f;
            if (mode == 1 && e == 1) {
#pragma unroll
                for (int j = 0; j < 8; ++j) { const int c = col0 - 1280 + j; lb[j] = fast_rcp(1.f + __expf(lbraw[c] - lbraw[512 + c])); }
            }
#pragma unroll
            for (int ai = 0; ai < 2; ++ai)
#pragma unroll
                for (int m = 0; m < 4; ++m) {
                    const int r = ai * 128 + wr * 64 + m * 16 + fr; const float rs = tb[r]; const size_t row = (size_t)(u.pm * 256 + r);
                    float v[8];
#pragma unroll
                    for (int n = 0; n < 2; ++n)
#pragma unroll
                        for (int j = 0; j < 4; ++j) v[n * 4 + j] = acc[ai][bj][m][n][j] * rs;
                    if (mode == 0) {
                        u32x4 w; w.x = cvt_pk_bf16(v[0], v[1]); w.y = cvt_pk_bf16(v[2], v[3]); w.z = cvt_pk_bf16(v[4], v[5]); w.w = cvt_pk_bf16(v[6], v[7]);
                        *(u32x4*)(P + row * MIXIN + col0) = w;
                    } else if (mode == 1) {
#pragma unroll
                        for (int j = 0; j < 8; ++j) v[j] = lb[j] + (1.f - lb[j]) * sigmoidf_(v[j]);
                        float* d = F + row * 512 + (col0 - 1280);
                        *(f32x4*)d = (f32x4){v[0], v[1], v[2], v[3]}; *(f32x4*)(d + 4) = (f32x4){v[4], v[5], v[6], v[7]};
                    } else {
#pragma unroll
                        for (int j = 0; j < 8; ++j) v[j] = siluf_(v[j]);
                        float* d = QS + row * 512 + (col0 - 768);
                        *(f32x4*)d = (f32x4){v[0], v[1], v[2], v[3]}; *(f32x4*)(d + 4) = (f32x4){v[4], v[5], v[6], v[7]};
                    }
                }
        }
    }
};

struct EpiResid {
    static constexpr bool PERM = true; static constexpr int NVM = 32;
    const float* base32; bf16_t* xb; float* ssq; float alpha;
    __device__ __forceinline__ void issue(const Unit&, RsRegs&) const {}
    __device__ __forceinline__ void commit(int, const RsRegs&) const {}
    __device__ __forceinline__ void operator()(const f32x4 (&acc)[2][2][4][2], const Unit& u, int ui, int wr, int wc, int fr, int fq) const {
        const int col0 = u.pn * 256 + wc * 32 + 8 * fq;
#pragma unroll
        for (int ai = 0; ai < 2; ++ai)
#pragma unroll
            for (int m = 0; m < 4; ++m) {
                const size_t row = (size_t)(u.pm * 256 + ai * 128 + wr * 64 + m * 16 + fr); const size_t off = row * DM + col0;
                f32x4 bs[2][2];
                if (base32) {
#pragma unroll
                    for (int bj = 0; bj < 2; ++bj)
#pragma unroll
                        for (int n = 0; n < 2; ++n) bs[bj][n] = *(const f32x4*)(base32 + off + bj * 128 + n * 4);
                } else {
#pragma unroll
                    for (int bj = 0; bj < 2; ++bj) { const u32x4 w = *(const u32x4*)(xb + off + bj * 128);
                        bs[bj][0] = (f32x4){bflo(w.x), bfhi(w.x), bflo(w.y), bfhi(w.y)}; bs[bj][1] = (f32x4){bflo(w.z), bfhi(w.z), bflo(w.w), bfhi(w.w)}; }
                }
                float s = 0.f;
#pragma unroll
                for (int bj = 0; bj < 2; ++bj) {
                    const f32x4 o0 = bs[bj][0] + acc[ai][bj][m][0] * alpha, o1 = bs[bj][1] + acc[ai][bj][m][1] * alpha;
                    u32x4 w; w.x = cvt_pk_bf16(o0[0], o0[1]); w.y = cvt_pk_bf16(o0[2], o0[3]); w.z = cvt_pk_bf16(o1[0], o1[1]); w.w = cvt_pk_bf16(o1[2], o1[3]);
                    *(u32x4*)(xb + off + bj * 128) = w;
                    s += ((o0[0] * o0[0] + o0[1] * o0[1]) + (o0[2] * o0[2] + o0[3] * o0[3])) + ((o1[0] * o1[0] + o1[1] * o1[1]) + (o1[2] * o1[2] + o1[3] * o1[3]));
                }
                s += __shfl_xor(s, 16); s += __shfl_xor(s, 32);
                if (fq == 0) ssq[row * 32 + u.pn * 4 + wc] = s;
                asm volatile("" ::: "memory");
            }
    }
};

struct EpiGlu {
    static constexpr bool PERM = true; static constexpr int NVM = 16;
    bf16_t* xb; float* ssq;
    __device__ __forceinline__ void issue(const Unit&, RsRegs&) const {}
    __device__ __forceinline__ void commit(int, const RsRegs&) const {}
    __device__ __forceinline__ void operator()(const f32x4 (&acc)[2][2][4][2], const Unit& u, int ui, int wr, int wc, int fr, int fq) const {
        const int col0 = u.pn * 128 + wc * 32 + 8 * fq;
#pragma unroll
        for (int ai = 0; ai < 2; ++ai)
#pragma unroll
            for (int m = 0; m < 4; ++m) {
                const size_t row = (size_t)(u.pm * 256 + ai * 128 + wr * 64 + m * 16 + fr); const size_t off = row * DM + col0;
                const u32x4 bw = *(const u32x4*)(xb + off);
                const float b[8] = {bflo(bw.x), bfhi(bw.x), bflo(bw.y), bfhi(bw.y), bflo(bw.z), bfhi(bw.z), bflo(bw.w), bfhi(bw.w)};
                float o[8]; float s = 0.f;
#pragma unroll
                for (int n = 0; n < 2; ++n)
#pragma unroll
                    for (int j = 0; j < 4; ++j) { o[n * 4 + j] = b[n * 4 + j] + acc[ai][0][m][n][j] * sigmoidf_(acc[ai][1][m][n][j]); s += o[n * 4 + j] * o[n * 4 + j]; }
                u32x4 w; w.x = cvt_pk_bf16(o[0], o[1]); w.y = cvt_pk_bf16(o[2], o[3]); w.z = cvt_pk_bf16(o[4], o[5]); w.w = cvt_pk_bf16(o[6], o[7]);
                *(u32x4*)(xb + off) = w;
                s += __shfl_xor(s, 16); s += __shfl_xor(s, 32);
                if (fq == 0) ssq[row * 32 + u.pn * 4 + wc] = s;
                asm volatile("" ::: "memory");
            }
    }
};

struct Params {
    const float *x, *norm_g, *ffn_w_in, *ffn_w_out, *mix_w_in, *attn_sinks, *hgrn_lb, *mix_w_out;
    const float *s5_a_re, *s5_a_im, *s5_log_step, *s5_b_re, *s5_b_im, *s5_c_re, *s5_c_im, *s5_d, *s5_w_glu, *final_g;
    float* out; unsigned char* ws;
};

struct TItem { const float* W; bf16_t* WT; const float* gs; int K, N, ileave, item; };
__device__ __forceinline__ void titem_load(const TItem& t, int lane, f32x4 (&w)[8], float (&gsc)[8]) {
    const int nblk = t.N / 32, kb = t.item / nblk, nb = t.item % nblk, k0 = 64 * kb, n0 = 32 * nb;
#pragma unroll
    for (int i = 0; i < 8; ++i) { const int kk = 8 * i + (lane >> 3); w[i] = *(const f32x4*)(t.W + (size_t)(k0 + kk) * t.N + n0 + 4 * (lane & 7)); gsc[i] = t.gs ? t.gs[k0 + kk] : 1.f; }
}
__device__ __forceinline__ void titem_process(const TItem& t, int lane, LAS float* scr, const f32x4 (&w)[8], const float (&gsc)[8]) {
    const int nblk = t.N / 32, kb = t.item / nblk, nb = t.item % nblk, k0 = 64 * kb, n0 = 32 * nb, K = t.K;
#pragma unroll
    for (int i = 0; i < 8; ++i) { const int kk = 8 * i + (lane >> 3); LAS float* d = scr + kk * 33 + 4 * (lane & 7); const f32x4 v = w[i] * gsc[i]; d[0] = v.x; d[1] = v.y; d[2] = v.z; d[3] = v.w; if ((i & 1) == 1) asm volatile("s_waitcnt lgkmcnt(0)" ::: "memory"); }
    asm volatile("s_waitcnt lgkmcnt(0)" ::: "memory");
    int d0 = n0;
    if (t.ileave) { const int half = t.N >> 1; d0 = (n0 < half) ? ((n0 >> 7) * 256 + (n0 & 127)) : (((n0 - half) >> 7) * 256 + 128 + ((n0 - half) & 127)); }
    const int c = lane & 7;
#pragma unroll
    for (int j = 0; j < 4; ++j) { const int n = (lane >> 3) + 8 * j; const LAS float* s = scr + (8 * c) * 33 + n;
        u32x4 o; o.x = cvt_pk_bf16(s[0 * 33], s[1 * 33]); o.y = cvt_pk_bf16(s[2 * 33], s[3 * 33]); o.z = cvt_pk_bf16(s[4 * 33], s[5 * 33]); o.w = cvt_pk_bf16(s[6 * 33], s[7 * 33]);
        *(u32x4*)(t.WT + (size_t)(d0 + n) * K + k0 + 8 * c) = o; }
    asm volatile("s_waitcnt lgkmcnt(0)" ::: "memory");
}
constexpr int I_FI = (DM / 64) * (2 * DFF / 32), I_FO = (DFF / 64) * (DM / 32), I_MI = (DM / 64) * (MIXIN / 32), I_MO = (DM / 64) * (DM / 32), I_GL = (DM / 64) * (2 * DM / 32);
constexpr int NITEMS = 8 * I_FI + 8 * I_FO + 2 * I_MI + 2 * I_MO + 2 * I_GL;
__device__ __forceinline__ TItem decode_item(const Params& p, int r) {
    unsigned char* ws = p.ws; TItem t;
    if (r < 8 * I_FI) { const int mi = r / I_FI, l = mi >> 1, j = mi & 1;
        t.W = p.ffn_w_in + (size_t)mi * DM * 2 * DFF; t.K = DM; t.N = 2 * DFF; t.WT = (bf16_t*)(ws + WS_WFFN_IN + mi * SZ_WFFN_IN); t.gs = p.norm_g + (size_t)(l * 3 + (j ? 2 : 0)) * DM; t.ileave = 1; t.item = r - mi * I_FI; return t; }
    r -= 8 * I_FI;
    if (r < 8 * I_FO) { const int mi = r / I_FO;
        t.W = p.ffn_w_out + (size_t)mi * DFF * DM; t.K = DFF; t.N = DM; t.WT = (bf16_t*)(ws + WS_WFFN_OUT + mi * SZ_WFFN_OUT); t.gs = nullptr; t.ileave = 0; t.item = r - mi * I_FO; return t; }
    r -= 8 * I_FO;
    if (r < 2 * I_MI) { const int mi = r / I_MI;
        t.W = p.mix_w_in + (size_t)mi * DM * MIXIN; t.K = DM; t.N = MIXIN; t.WT = (bf16_t*)(ws + WS_WMIX_IN + mi * SZ_WMIX_IN); t.gs = p.norm_g + (size_t)((2 * mi) * 3 + 1) * DM; t.ileave = 0; t.item = r - mi * I_MI; return t; }
    r -= 2 * I_MI;
    if (r < 2 * I_MO) { const int mi = r / I_MO;
        t.W = p.mix_w_out + (size_t)mi * DM * DM; t.K = DM; t.N = DM; t.WT = (bf16_t*)(ws + WS_WMIX_OUT + mi * SZ_WMIX_OUT); t.gs = nullptr; t.ileave = 0; t.item = r - mi * I_MO; return t; }
    r -= 2 * I_MO;
    { const int mi = r / I_GL;
        t.W = p.s5_w_glu + (size_t)mi * DM * 2 * DM; t.K = DM; t.N = 2 * DM; t.WT = (bf16_t*)(ws + WS_WGLU + mi * SZ_WGLU); t.gs = nullptr; t.ileave = 1; t.item = r - mi * I_GL; return t; }
}

__device__ __forceinline__ void prologue_phase(const Params& p, LAS unsigned char* lds, int G) {
    const int tid = otid(), lane = tid & 63, wave = __builtin_amdgcn_readfirstlane(tid >> 6);
    LAS float* scr = (LAS float*)(lds + wave * 16384);
    const int gw = obid() * NWAVES + wave, NGW = G * NWAVES;
    unsigned char* ws = p.ws;
    for (int it = gw; it < NITEMS; it += 2 * NGW) {
        const bool hb = it + NGW < NITEMS;
        const TItem a = decode_item(p, it), b = decode_item(p, hb ? it + NGW : it);
        f32x4 wa[8], wb[8]; float ga[8], gb[8];
        titem_load(a, lane, wa, ga); titem_load(b, lane, wb, gb);
        titem_process(a, lane, scr, wa, ga);
        if (hb) titem_process(b, lane, scr, wb, gb);
    }
    bf16_t* xb = (bf16_t*)(ws + WS_XB); float* ssq = (float*)(ws + WS_SSQ);
    for (int m = gw; m < M; m += 2 * NGW) {
        const int m2 = (m + NGW < M) ? (m + NGW) : m;
        const f32x4* xr0 = (const f32x4*)(p.x + (size_t)m * DM) + lane; const f32x4* xr1 = (const f32x4*)(p.x + (size_t)m2 * DM) + lane;
        f32x4 v0[4], v1[4]; float s0 = 0.f, s1 = 0.f;
#pragma unroll
        for (int j = 0; j < 4; ++j) { v0[j] = xr0[64 * j]; v1[j] = xr1[64 * j]; }
#pragma unroll
        for (int j = 0; j < 4; ++j) { s0 += (v0[j].x * v0[j].x + v0[j].y * v0[j].y) + (v0[j].z * v0[j].z + v0[j].w * v0[j].w); s1 += (v1[j].x * v1[j].x + v1[j].y * v1[j].y) + (v1[j].z * v1[j].z + v1[j].w * v1[j].w); }
        s0 = wave_sum(s0); s1 = wave_sum(s1);
        u32x2* o0 = (u32x2*)(xb + (size_t)m * DM) + lane; u32x2* o1 = (u32x2*)(xb + (size_t)m2 * DM) + lane;
#pragma unroll
        for (int j = 0; j < 4; ++j) { u32x2 w; w.x = cvt_pk_bf16(v0[j].x, v0[j].y); w.y = cvt_pk_bf16(v0[j].z, v0[j].w); o0[64 * j] = w;
                                      u32x2 w2; w2.x = cvt_pk_bf16(v1[j].x, v1[j].y); w2.y = cvt_pk_bf16(v1[j].z, v1[j].w); o1[64 * j] = w2; }
        if (lane < 16) { ssq[(size_t)m * 32 + lane] = (lane == 0) ? s0 : 0.f; ssq[(size_t)m2 * 32 + lane] = (lane == 0) ? s1 : 0.f; }
    }
}

constexpr int HQD = 0, HKI = 8704, HKET = 17408, HVT = 27648, HDEC = 37888, HCS = 38400, HPS = 40448;
__device__ __forceinline__ bf16x8 pack8(const f32x4& a, const f32x4& b) {
    u32x4 w; w.x = cvt_pk_bf16(a[0], a[1]); w.y = cvt_pk_bf16(a[2], a[3]); w.z = cvt_pk_bf16(b[0], b[1]); w.w = cvt_pk_bf16(b[2], b[3]); return __builtin_bit_cast(bf16x8, w);
}
__device__ __forceinline__ bf16x8 ld2x8(const LAS bf16_t* p0, const LAS bf16_t* p1) {
    const u32x2 a = *(const LAS u32x2*)p0, b = *(const LAS u32x2*)p1; u32x4 w; w.x = a.x; w.y = a.y; w.z = b.x; w.w = b.y; return __builtin_bit_cast(bf16x8, w);
}
template <bool OUT>
__device__ __forceinline__ void hgrn_mma(const Params& p, int it, LAS unsigned char* lds) {
    const int tid = otid(), lane = tid & 63, wave = __builtin_amdgcn_readfirstlane(tid >> 6), fr = lane & 15, fq = lane >> 4;
    const int b = it >> 6, h = (it >> 4) & 3, seg = it & 15;
    const int dk = tid & 127, tq = tid >> 7;
    LAS bf16_t* Qd = (LAS bf16_t*)(lds + HQD); LAS bf16_t* Ki = (LAS bf16_t*)(lds + HKI); LAS bf16_t* KeT = (LAS bf16_t*)(lds + HKET); LAS bf16_t* VT = (LAS bf16_t*)(lds + HVT);
    LAS float* dec = (LAS float*)(lds + HDEC); LAS float* cs = (LAS float*)(lds + HCS); LAS float* ps = (LAS float*)(lds + HPS);
    const size_t tok0 = (size_t)b * SEQ + (size_t)seg * HSEG;
    const float* Fp = (const float*)(p.ws + WS_F) + tok0 * 512 + h * 128 + dk;
    const float* Qp = (const float*)(p.ws + WS_QS) + tok0 * 512 + h * 128 + dk;
    const bf16_t* proj = (const bf16_t*)(p.ws + WS_ACT);
    const bf16_t* Vp = proj + tok0 * MIXIN + 1792 + h * 128 + dk;
    bf16_t* cat = (bf16_t*)(p.ws + WS_CAT);
    f32x4* HS4 = (f32x4*)(p.ws + WS_HS); float* HD = (float*)(p.ws + WS_HD);
    f32x4 S[8];
#pragma unroll
    for (int mb = 0; mb < 8; ++mb) S[mb] = (f32x4){0.f, 0.f, 0.f, 0.f};
    if (OUT) {
        f32x4 Pd[8];
#pragma unroll
        for (int mb = 0; mb < 8; ++mb) Pd[mb] = (f32x4){1.f, 1.f, 1.f, 1.f};
#pragma unroll 2
        for (int v = seg - 1; v >= 0; --v) { const int itv = it - seg + v;
#pragma unroll
            for (int mb = 0; mb < 8; ++mb) { const f32x4 x = HS4[(((size_t)itv * 8 + wave) * 8 + mb) * 64 + lane]; const f32x4 d4 = *(const f32x4*)(HD + (size_t)itv * 128 + mb * 16 + fq * 4);
                S[mb] = S[mb] + Pd[mb] * x; Pd[mb] = Pd[mb] * d4; } }
    }
    float dlog = 0.f;
    const int dvrow = wave * 16 + fr;
    const bf16_t* Gp = proj + tok0 * MIXIN + 2304 + h * 128 + wave * 16 + fq * 4;
    float fvA[8], qvA[8], fvB[8], qvB[8]; unsigned short vvA[8], vvB[8]; u32x2 gA0, gA1, gB0, gB1;
#define HG_LOAD(fv, qv, vv, g0, g1, cc) do { const int c_ = (cc) < (HSEG / 32) ? (cc) : (HSEG / 32 - 1); \
        _Pragma("unroll") for (int r = 0; r < 8; ++r) { const size_t t = (size_t)(c_ * 32 + tq * 8 + r); fv[r] = Fp[t * 512]; if (OUT) qv[r] = Qp[t * 512]; vv[r] = Vp[t * MIXIN]; } \
        if (OUT) { g0 = *(const u32x2*)(Gp + (size_t)(c_ * 32 + fr) * MIXIN); g1 = *(const u32x2*)(Gp + (size_t)(c_ * 32 + 16 + fr) * MIXIN); } } while (0)
#define HG_CHUNK(fv, qv, vv, g0, g1, c) do { \
        float cum[8]; float run = 0.f; \
        _Pragma("unroll") for (int r = 0; r < 8; ++r) { run += __logf(fv[r]); cum[r] = run; } \
        if (OUT && (c) > 0) { *(u32x2*)(cat + ptok * DM + 512 + h * 128 + wave * 16 + fq * 4) = pwA; *(u32x2*)(cat + (ptok + 16) * DM + 512 + h * 128 + wave * 16 + fq * 4) = pwB; } \
        cs[tq * 128 + dk] = run; \
        asm volatile("s_waitcnt lgkmcnt(0)" ::: "memory"); __builtin_amdgcn_s_barrier(); asm volatile("" ::: "memory");        \
        float off = 0.f, tot = 0.f; \
        _Pragma("unroll") for (int q = 0; q < 4; ++q) { const float x = cs[q * 128 + dk]; tot += x; if (q < tq) off += x; } \
        float ke[8]; \
        _Pragma("unroll") for (int r = 0; r < 8; ++r) { const float cm = cum[r] + off, k = 1.f - fv[r]; const int t = tq * 8 + r; \
            if (OUT) { Qd[t * 136 + dk] = (bf16_t)(cvt_pk_bf16(qv[r] * __expf(cm), 0.f) & 0xffffu); Ki[t * 136 + dk] = (bf16_t)(cvt_pk_bf16(k * __expf(-cm), 0.f) & 0xffffu); } \
            ke[r] = k * __expf(tot - cm); if ((r & 3) == 3) asm volatile("s_waitcnt lgkmcnt(0)" ::: "memory"); } \
        { u32x4 w; w.x = cvt_pk_bf16(ke[0], ke[1]); w.y = cvt_pk_bf16(ke[2], ke[3]); w.z = cvt_pk_bf16(ke[4], ke[5]); w.w = cvt_pk_bf16(ke[6], ke[7]); *(LAS u32x4*)(KeT + dk * 40 + tq * 8) = w; } \
        { u32x4 w; w.x = (unsigned)vv[0] | ((unsigned)vv[1] << 16); w.y = (unsigned)vv[2] | ((unsigned)vv[3] << 16); w.z = (unsigned)vv[4] | ((unsigned)vv[5] << 16); w.w = (unsigned)vv[6] | ((unsigned)vv[7] << 16); \
          *(LAS u32x4*)(VT + dk * 40 + tq * 8) = w; } \
        if (tq == 0) { dec[dk] = __expf(tot); dlog += tot; } \
        const u32x2 gc0 = g0, gc1 = g1; \
        HG_LOAD(fv, qv, vv, g0, g1, (c) + 2);                                                                                    \
        asm volatile("s_waitcnt lgkmcnt(0)" ::: "memory"); __builtin_amdgcn_s_barrier(); asm volatile("" ::: "memory");        \
        f32x4 o0 = (f32x4){0.f, 0.f, 0.f, 0.f}, o1 = o0; \
        if (OUT) { \
            f32x4 sc00 = o0, sc01 = o0, sc11 = o0; \
            _Pragma("unroll") for (int ks = 0; ks < 4; ++ks) { \
                const bf16x8 a0 = *(const LAS bf16x8*)(Ki + fr * 136 + ks * 32 + fq * 8), a1 = *(const LAS bf16x8*)(Ki + (16 + fr) * 136 + ks * 32 + fq * 8); \
                const bf16x8 b0 = *(const LAS bf16x8*)(Qd + fr * 136 + ks * 32 + fq * 8), b1 = *(const LAS bf16x8*)(Qd + (16 + fr) * 136 + ks * 32 + fq * 8); \
                sc00 = __builtin_amdgcn_mfma_f32_16x16x32_bf16(a0, b0, sc00, 0, 0, 0); \
                sc01 = __builtin_amdgcn_mfma_f32_16x16x32_bf16(a0, b1, sc01, 0, 0, 0); \
                sc11 = __builtin_amdgcn_mfma_f32_16x16x32_bf16(a1, b1, sc11, 0, 0, 0); asm volatile("s_waitcnt lgkmcnt(0)" ::: "memory"); } \
            _Pragma("unroll") for (int j = 0; j < 4; ++j) if (fq * 4 + j > fr) { sc00[j] = 0.f; sc11[j] = 0.f; } \
            const bf16x8 Pb0 = pack8(sc00, (f32x4){0.f, 0.f, 0.f, 0.f}), Pb1 = pack8(sc01, sc11); \
            const bf16x8 Va = ld2x8(VT + dvrow * 40 + fq * 4, VT + dvrow * 40 + 16 + fq * 4); \
            f32x4 o0b = o0, o1b = o0; \
            o0 = __builtin_amdgcn_mfma_f32_16x16x32_bf16(Va, Pb0, o0, 0, 0, 0); \
            o1 = __builtin_amdgcn_mfma_f32_16x16x32_bf16(Va, Pb1, o1, 0, 0, 0); \
            _Pragma("unroll") for (int ks = 0; ks < 4; ++ks) { \
                const bf16x8 Sa = pack8(S[2 * ks], S[2 * ks + 1]); \
                const bf16x8 q0 = ld2x8(Qd + fr * 136 + (2 * ks) * 16 + fq * 4, Qd + fr * 136 + (2 * ks + 1) * 16 + fq * 4); \
                const bf16x8 q1 = ld2x8(Qd + (16 + fr) * 136 + (2 * ks) * 16 + fq * 4, Qd + (16 + fr) * 136 + (2 * ks + 1) * 16 + fq * 4); \
                if (ks & 1) { o0b = __builtin_amdgcn_mfma_f32_16x16x32_bf16(Sa, q0, o0b, 0, 0, 0); o1b = __builtin_amdgcn_mfma_f32_16x16x32_bf16(Sa, q1, o1b, 0, 0, 0); } \
                else { o0 = __builtin_amdgcn_mfma_f32_16x16x32_bf16(Sa, q0, o0, 0, 0, 0); o1 = __builtin_amdgcn_mfma_f32_16x16x32_bf16(Sa, q1, o1, 0, 0, 0); } asm volatile("s_waitcnt lgkmcnt(0)" ::: "memory"); } \
            o0 = o0 + o0b; o1 = o1 + o1b; \
        } \
        {     \
            const bf16x8 vb = *(const LAS bf16x8*)(VT + dvrow * 40 + fq * 8); \
            _Pragma("unroll") for (int mb = 0; mb < 8; ++mb) { const f32x4 d4 = *(const LAS f32x4*)(dec + mb * 16 + fq * 4); const bf16x8 ka = *(const LAS bf16x8*)(KeT + (mb * 16 + fr) * 40 + fq * 8); \
                S[mb] = __builtin_amdgcn_mfma_f32_16x16x32_bf16(ka, vb, S[mb] * d4, 0, 0, 0); if (mb & 1) asm volatile("s_waitcnt lgkmcnt(0)" ::: "memory"); } \
        } \
        if (OUT) { \
            const size_t tokA = tok0 + (size_t)(c) * 32 + fr, tokB = tokA + 16; \
            float pp0 = (o0[0] * o0[0] + o0[1] * o0[1]) + (o0[2] * o0[2] + o0[3] * o0[3]), pp1 = (o1[0] * o1[0] + o1[1] * o1[1]) + (o1[2] * o1[2] + o1[3] * o1[3]); \
            pp0 += __shfl_xor(pp0, 16); pp0 += __shfl_xor(pp0, 32); pp1 += __shfl_xor(pp1, 16); pp1 += __shfl_xor(pp1, 32); \
            if (fq == 0) { ps[wave * 32 + fr] = pp0; ps[wave * 32 + 16 + fr] = pp1; } \
            asm volatile("s_waitcnt lgkmcnt(0)" ::: "memory"); __builtin_amdgcn_s_barrier(); asm volatile("" ::: "memory");    \
            float s0 = 0.f, s1 = 0.f; \
            _Pragma("unroll") for (int w = 0; w < 8; ++w) { s0 += ps[w * 32 + fr]; s1 += ps[w * 32 + 16 + fr]; } \
            const float rn0 = rsqrtf(s0 * (1.f / 128.f) + EPS), rn1 = rsqrtf(s1 * (1.f / 128.f) + EPS); \
            u32x2 wA, wB; \
            wA.x = cvt_pk_bf16(o0[0] * rn0 * siluf_(bflo(gc0.x)), o0[1] * rn0 * siluf_(bfhi(gc0.x))); wA.y = cvt_pk_bf16(o0[2] * rn0 * siluf_(bflo(gc0.y)), o0[3] * rn0 * siluf_(bfhi(gc0.y))); \
            wB.x = cvt_pk_bf16(o1[0] * rn1 * siluf_(bflo(gc1.x)), o1[1] * rn1 * siluf_(bfhi(gc1.x))); wB.y = cvt_pk_bf16(o1[2] * rn1 * siluf_(bflo(gc1.y)), o1[3] * rn1 * siluf_(bfhi(gc1.y))); \
            pwA = wA; pwB = wB; ptok = tokA; (void)tokB;        \
        } } while (0)
    u32x2 pwA = {0u, 0u}, pwB = {0u, 0u}; size_t ptok = 0;
    HG_LOAD(fvA, qvA, vvA, gA0, gA1, 0);
    HG_LOAD(fvB, qvB, vvB, gB0, gB1, 1);
#pragma unroll 1
    for (int c = 0; c < HSEG / 32; c += 2) {
        HG_CHUNK(fvA, qvA, vvA, gA0, gA1, c);
        HG_CHUNK(fvB, qvB, vvB, gB0, gB1, c + 1);
    }
    if (OUT) { *(u32x2*)(cat + ptok * DM + 512 + h * 128 + wave * 16 + fq * 4) = pwA; *(u32x2*)(cat + (ptok + 16) * DM + 512 + h * 128 + wave * 16 + fq * 4) = pwB; }
#undef HG_LOAD
#undef HG_CHUNK
    if (!OUT) {
#pragma unroll
        for (int mb = 0; mb < 8; ++mb) HS4[(((size_t)it * 8 + wave) * 8 + mb) * 64 + lane] = S[mb];
        if (tq == 0) HD[(size_t)it * 128 + dk] = __expf(dlog);
    }
    __syncthreads();
}


constexpr int AKS = 72, AVS = 268;
constexpr int AK_OFF = 0, AV_OFF = 256 * AKS * 2;
__device__ __forceinline__ void attn_mma(const Params& p, int e, LAS unsigned char* lds, int G) {
    const int tid = otid(), lane = tid & 63, wave = __builtin_amdgcn_readfirstlane(tid >> 6), fr = lane & 15, fq = lane >> 4;
    LAS bf16_t* Ks = (LAS bf16_t*)(lds + AK_OFF); LAS bf16_t* VTs = (LAS bf16_t*)(lds + AV_OFF);
    const bf16_t* P = (const bf16_t*)(p.ws + WS_ACT); bf16_t* cat = (bf16_t*)(p.ws + WS_CAT);
    const int g = wave >> 1, half = wave & 1;
    for (int item = obid(); item < 512; item += G) {
        const int kvh = item & 1, nbi = (item >> 1) & 63, b = item >> 7, hq = kvh * 4 + g;
        const size_t tokblk = (size_t)b * SEQ + (size_t)nbi * 128;
        const bf16_t* qsrc = P + (tokblk + half * 64 + fr) * MIXIN + hq * 64 + fq * 8;
        bf16x8 qn0 = *(const bf16x8*)qsrc, qn1 = *(const bf16x8*)(qsrc + 32);
#pragma unroll
        for (int i = 0; i < 4; ++i) {
            const int id = tid + 512 * i, row = id >> 3, ch = id & 7;
            int tk = nbi * 128 - 128 + row; if (tk < 0) tk = 0;
            const bf16_t* src = P + ((size_t)b * SEQ + tk) * MIXIN + 512 + kvh * 64 + ch * 8;
            const u32x4 kq = *(const u32x4*)src, vq = *(const u32x4*)(src + 128);
            *(LAS u32x4*)(Ks + row * AKS + ch * 8) = kq;
            LAS bf16_t* vd = VTs + (ch * 8) * AVS + row;
            vd[0 * AVS] = (bf16_t)(vq.x & 0xffffu); vd[1 * AVS] = (bf16_t)(vq.x >> 16); vd[2 * AVS] = (bf16_t)(vq.y & 0xffffu); vd[3 * AVS] = (bf16_t)(vq.y >> 16);
            vd[4 * AVS] = (bf16_t)(vq.z & 0xffffu); vd[5 * AVS] = (bf16_t)(vq.z >> 16); vd[6 * AVS] = (bf16_t)(vq.w & 0xffffu); vd[7 * AVS] = (bf16_t)(vq.w >> 16);
            asm volatile("s_waitcnt lgkmcnt(0)" ::: "memory");
        }
        asm volatile("s_waitcnt lgkmcnt(0)" ::: "memory"); __builtin_amdgcn_s_barrier(); asm volatile("" ::: "memory");
        const float slope = exp2f(-(float)(hq + 1)), sink = p.attn_sinks[e * 8 + hq];
#pragma unroll 1
        for (int rb4 = 0; rb4 < 4; ++rb4) {
            const int rbase = half * 64 + rb4 * 16, rb = rbase >> 4, irow = rbase + fr;
            const bf16x8 q0 = qn0, q1 = qn1;
            { const int rn = rb4 < 3 ? rb4 + 1 : 3; qn0 = *(const bf16x8*)(qsrc + (size_t)rn * 16 * MIXIN); qn1 = *(const bf16x8*)(qsrc + (size_t)rn * 16 * MIXIN + 32); }
            f32x4 sc[10];
#pragma unroll
            for (int kbi = 0; kbi < 10; ++kbi) {
                const int kb = (rb + kbi) < 15 ? (rb + kbi) : 15;
                const bf16x8 a0 = *(const LAS bf16x8*)(Ks + (kb * 16 + fr) * AKS + fq * 8), a1 = *(const LAS bf16x8*)(Ks + (kb * 16 + fr) * AKS + 32 + fq * 8);
                f32x4 r = __builtin_amdgcn_mfma_f32_16x16x32_bf16(a0, q0, (f32x4){0.f, 0.f, 0.f, 0.f}, 0, 0, 0);
                sc[kbi] = __builtin_amdgcn_mfma_f32_16x16x32_bf16(a1, q1, r, 0, 0, 0);
                if (kbi & 1) asm volatile("s_waitcnt lgkmcnt(0)" ::: "memory");
            }
            float mx = sink;
#pragma unroll
            for (int kbi = 0; kbi < 10; ++kbi)
#pragma unroll
                for (int jj = 0; jj < 4; ++jj) {
                    const int j = (rb + kbi) * 16 + fq * 4 + jj, dist = irow + 128 - j;
                    const bool valid = (dist >= 0) && (dist < 128) && (nbi > 0 || j >= 128);
                    const float sv = valid ? (sc[kbi][jj] * 0.125f - slope * (float)dist) : -INFINITY;
                    sc[kbi][jj] = sv; mx = fmaxf(mx, sv);
                }
            mx = fmaxf(mx, __shfl_xor(mx, 16)); mx = fmaxf(mx, __shfl_xor(mx, 32));
            float l = 0.f;
#pragma unroll
            for (int kbi = 0; kbi < 10; ++kbi)
#pragma unroll
                for (int jj = 0; jj < 4; ++jj) { const float pv = __expf(sc[kbi][jj] - mx); sc[kbi][jj] = pv; l += pv; }
            l += __shfl_xor(l, 16); l += __shfl_xor(l, 32); l += __expf(sink - mx);
            f32x4 O[4];
#pragma unroll
            for (int db = 0; db < 4; ++db) O[db] = (f32x4){0.f, 0.f, 0.f, 0.f};
#pragma unroll
            for (int pi = 0; pi < 5; ++pi) {
                const int kb0 = (rb + 2 * pi) < 15 ? (rb + 2 * pi) : 15, kb1 = (rb + 2 * pi + 1) < 15 ? (rb + 2 * pi + 1) : 15;
                const bf16x8 Pb = pack8(sc[2 * pi], sc[2 * pi + 1]);
#pragma unroll
                for (int db = 0; db < 4; ++db) {
                    const bf16x8 Va = ld2x8(VTs + (db * 16 + fr) * AVS + kb0 * 16 + fq * 4, VTs + (db * 16 + fr) * AVS + kb1 * 16 + fq * 4);
                    O[db] = __builtin_amdgcn_mfma_f32_16x16x32_bf16(Va, Pb, O[db], 0, 0, 0);
                }
                asm volatile("s_waitcnt lgkmcnt(0)" ::: "memory");
            }
            const float inv = fast_rcp(l);
            bf16_t* op = cat + (tokblk + irow) * DM + hq * 64 + fq * 4;
#pragma unroll
            for (int db = 0; db < 4; ++db) { u32x2 w; w.x = cvt_pk_bf16(O[db][0] * inv, O[db][1] * inv); w.y = cvt_pk_bf16(O[db][2] * inv, O[db][3] * inv); *(u32x2*)(op + db * 16) = w; }
        }
        asm volatile("s_waitcnt lgkmcnt(0)" ::: "memory"); __builtin_amdgcn_s_barrier(); asm volatile("" ::: "memory");
    }
}

constexpr int S5_SEG = SEQ / NWAVES;
constexpr int S5_SEGA = 944;
static_assert(S5_SEGA % 16 == 0 && S5_SEGA < 1024 && (SEQ - (NWAVES - 1) * S5_SEGA) % 16 == 0, "S5 segment geometry");
__device__ __forceinline__ void s5_phase(const Params& p, int layer, int oi, LAS unsigned char* lds, int G) {
    const int tid = otid(), lane = tid & 63, wave = __builtin_amdgcn_readfirstlane(tid >> 6);
    LAS unsigned char* wl = lds + wave * 16384;
    LAS bf16_t* U_bf = (LAS bf16_t*)wl;
    LAS float* U_f = (LAS float*)(wl + 1024);
    LAS float* BU = (LAS float*)(wl + 2048);
    LAS bf16_t* XH = (LAS bf16_t*)(wl + 2048 + 8448);
    LAS float* XCH = (LAS float*)(lds + TBL_OFF + 2048);
    const bf16_t* X = (const bf16_t*)(p.ws + WS_XB); const float* ssq = (const float*)(p.ws + WS_SSQ); bf16_t* yb = (bf16_t*)(p.ws + WS_CAT);
    const int fr = lane & 15, fq = lane >> 4;
    const int bid_ = obid(), vb_ = (G % 8 == 0) ? (bid_ % 8) * (G / 8) + bid_ / 8 : bid_;
    for (int item = vb_; item < BATCH * 64; item += G) {
        const int b = item >> 6, g = item & 63;
        const size_t gp = ((size_t)oi * 64 + g) * 64 + lane;
        const float lr = p.s5_a_re[gp], li = p.s5_a_im[gp];
        const float step = __expf(p.s5_log_step[oi * 64 + g]);
        const float mag = expf(step * lr);
        float sn, cs; sincosf(step * li, &sn, &cs);
        const float abr = mag * cs, abi = mag * sn;
        const float den = lr * lr + li * li;
        const float cfr = ((abr - 1.f) * lr + abi * li) / den, cfi = (abi * lr - (abr - 1.f) * li) / den;
        {
            LAS bf16_t* BBm = (LAS bf16_t*)BU;
            const f32x4* brp = (const f32x4*)(p.s5_b_re + gp * 16); const f32x4* bip = (const f32x4*)(p.s5_b_im + gp * 16);
            unsigned wr_[8], wi_[8];
#pragma unroll
            for (int c4 = 0; c4 < 4; ++c4) { const f32x4 br = brp[c4], bi = bip[c4];
                float r_[4], i_[4];
#pragma unroll
                for (int j = 0; j < 4; ++j) { r_[j] = cfr * br[j] - cfi * bi[j]; i_[j] = cfr * bi[j] + cfi * br[j]; }
                wr_[c4 * 2] = cvt_pk_bf16(r_[0], r_[1]); wr_[c4 * 2 + 1] = cvt_pk_bf16(r_[2], r_[3]); wi_[c4 * 2] = cvt_pk_bf16(i_[0], i_[1]); wi_[c4 * 2 + 1] = cvt_pk_bf16(i_[2], i_[3]); }
            LAS u32x4* rr = (LAS u32x4*)(BBm + lane * 32); LAS u32x4* ri = (LAS u32x4*)(BBm + (64 + lane) * 32);
            rr[0] = (u32x4){wr_[0], wr_[1], wr_[2], wr_[3]}; rr[1] = (u32x4){wr_[4], wr_[5], wr_[6], wr_[7]}; rr[2] = (u32x4){0u, 0u, 0u, 0u}; rr[3] = (u32x4){0u, 0u, 0u, 0u}; asm volatile("s_waitcnt lgkmcnt(0)" ::: "memory");
            ri[0] = (u32x4){wi_[0], wi_[1], wi_[2], wi_[3]}; ri[1] = (u32x4){wi_[4], wi_[5], wi_[6], wi_[7]}; ri[2] = (u32x4){0u, 0u, 0u, 0u}; ri[3] = (u32x4){0u, 0u, 0u, 0u};
            asm volatile("" ::: "memory");
        }
        bf16x8 Bop[8], Cop[4];
#pragma unroll
        for (int nb = 0; nb < 8; ++nb) Bop[nb] = *(const LAS bf16x8*)((LAS bf16_t*)BU + (nb * 16 + fr) * 32 + fq * 8);
#pragma unroll
        for (int ks = 0; ks < 4; ++ks) {
            const float* src = ((ks < 2) ? p.s5_c_re : p.s5_c_im) + (((size_t)oi * 64 + g) * 16 + fr) * 64 + (ks & 1) * 32 + fq * 8;
            const f32x4 a = *(const f32x4*)src, c = *(const f32x4*)(src + 4); const float sg = (ks < 2) ? 1.f : -1.f;
            u32x4 w; w.x = cvt_pk_bf16(sg * a[0], sg * a[1]); w.y = cvt_pk_bf16(sg * a[2], sg * a[3]); w.z = cvt_pk_bf16(sg * c[0], sg * c[1]); w.w = cvt_pk_bf16(sg * c[2], sg * c[3]);
            Cop[ks] = __builtin_bit_cast(bf16x8, w);
        }
        const float dsk = p.s5_d[oi * DM + g * 16 + fr];
        const int ut = lane >> 2, ucq = lane & 3;
        const f32x4 gn4 = *(const f32x4*)(p.norm_g + (size_t)(layer * 3 + 1) * DM + g * 16 + ucq * 4);
        asm volatile("s_waitcnt lgkmcnt(0)" ::: "memory");
        { LAS u32x4* z = (LAS u32x4*)U_bf; z[lane] = (u32x4){0u, 0u, 0u, 0u}; } asm volatile("" ::: "memory");
        const size_t tokbase = (size_t)b * SEQ + (size_t)wave * S5_SEGA;
        float xr = 0.f, xi = 0.f;
        bf16_t yprev[4] = {0, 0, 0, 0};
#pragma unroll 1
        for (int pass = 0; pass < 2; ++pass) {
            const int seglen = (wave < NWAVES - 1) ? S5_SEGA : (pass ? (SEQ - (NWAVES - 1) * S5_SEGA) : 0);
            u32x2 xn = *(const u32x2*)(X + (tokbase + ut) * DM + g * 16 + ucq * 4);
            f32x4 sq = *(const f32x4*)(ssq + (tokbase + ut) * 32 + ucq * 4);
#pragma unroll 1
            for (int t0 = 0; t0 < seglen; t0 += 16) {
                const f32x4 xc = (f32x4){bflo(xn.x), bfhi(xn.x), bflo(xn.y), bfhi(xn.y)}, sc = sq;
                { const int tn = (t0 + 16 < seglen) ? (t0 + 16) : t0;
                  xn = *(const u32x2*)(X + (tokbase + tn + ut) * DM + g * 16 + ucq * 4); sq = *(const f32x4*)(ssq + (tokbase + tn + ut) * 32 + ucq * 4); }
                if (pass && t0 > 0) {
#pragma unroll
                    for (int j = 0; j < 4; ++j) yb[(tokbase + t0 - 16 + fq * 4 + j) * DM + g * 16 + fr] = yprev[j];
                }
                float s = (sc.x + sc.y) + (sc.z + sc.w);
                s += __int_as_float(__builtin_amdgcn_mov_dpp(__float_as_int(s), 0xB1, 0xF, 0xF, true));
                s += __int_as_float(__builtin_amdgcn_mov_dpp(__float_as_int(s), 0x4E, 0xF, 0xF, true));
                const float rs = rsqrtf(s * (1.f / DM) + EPS);
                const f32x4 u4 = xc * rs * gn4;
                *(LAS f32x4*)(U_f + ut * 16 + ucq * 4) = u4;
                { u32x2 w; w.x = cvt_pk_bf16(u4[0], u4[1]); w.y = cvt_pk_bf16(u4[2], u4[3]); *(LAS u32x2*)(U_bf + ut * 32 + ucq * 4) = w; } asm volatile("" ::: "memory");
                const bf16x8 ua = *(const LAS bf16x8*)(U_bf + fr * 32 + fq * 8);
#pragma unroll
                for (int nb = 0; nb < 8; ++nb) {
                    f32x4 r = __builtin_amdgcn_mfma_f32_16x16x32_bf16(ua, Bop[nb], (f32x4){0.f, 0.f, 0.f, 0.f}, 0, 0, 0);
#pragma unroll
                    for (int j = 0; j < 4; ++j) BU[(fq * 4 + j) * 132 + nb * 16 + fr] = r[j];
                } asm volatile("" ::: "memory");
                float br_[16], bi_[16];
#pragma unroll
                for (int tt = 0; tt < 16; ++tt) { br_[tt] = BU[tt * 132 + lane]; bi_[tt] = BU[tt * 132 + 64 + lane]; if ((tt & 7) == 7) asm volatile("s_waitcnt lgkmcnt(0)" ::: "memory"); }
#pragma unroll
                for (int tt = 0; tt < 16; ++tt) {
                    const float bur = br_[tt], bui = bi_[tt];
                    const float nxr = abr * xr - abi * xi + bur, nxi = abr * xi + abi * xr + bui;
                    xr = nxr; xi = nxi;
                    if (pass) { XH[tt * 136 + lane] = (bf16_t)(cvt_pk_bf16(xr, 0.f) & 0xffffu); XH[tt * 136 + 64 + lane] = (bf16_t)(cvt_pk_bf16(xi, 0.f) & 0xffffu); }
                } asm volatile("" ::: "memory");
                if (pass) {
                    f32x4 y = (f32x4){0.f, 0.f, 0.f, 0.f};
#pragma unroll
                    for (int ks = 0; ks < 4; ++ks) { const bf16x8 xa = *(const LAS bf16x8*)(XH + fr * 136 + ks * 32 + fq * 8); y = __builtin_amdgcn_mfma_f32_16x16x32_bf16(xa, Cop[ks], y, 0, 0, 0); }
#pragma unroll
                    for (int j = 0; j < 4; ++j) { const int t = fq * 4 + j; const float v = gelu_tanh(y[j] + dsk * U_f[t * 16 + fr]);
                        yprev[j] = (bf16_t)(cvt_pk_bf16(v, 0.f) & 0xffffu); }
                } asm volatile("" ::: "memory");
            }
            if (pass) {
#pragma unroll
                for (int j = 0; j < 4; ++j) yb[(tokbase + seglen - 16 + fq * 4 + j) * DM + g * 16 + fr] = yprev[j];
            }
            if (pass == 0) {
                XCH[(wave * 64 + lane) * 2] = xr; XCH[(wave * 64 + lane) * 2 + 1] = xi;
                float qr = abr, qi = abi, pr = 1.f, pi = 0.f;
#pragma unroll
                for (int q = 0; q < 10; ++q) {
                    if ((S5_SEGA >> q) & 1) { const float nr = pr * qr - pi * qi, ni = pr * qi + pi * qr; pr = nr; pi = ni; }
                    const float nr = qr * qr - qi * qi, ni = 2.f * qr * qi; qr = nr; qi = ni; }
                __syncthreads();
                float sr = 0.f, si = 0.f;
                for (int v = 0; v < wave; ++v) { const float er = XCH[(v * 64 + lane) * 2], ei = XCH[(v * 64 + lane) * 2 + 1];
                    const float nr = pr * sr - pi * si + er, ni = pr * si + pi * sr + ei; sr = nr; si = ni; }
                xr = sr; xi = si;
            }
        }
        __syncthreads();
    }
}

__device__ __forceinline__ void final_norm(const Params& p, int G) {
    const int tid = otid(), lane = tid & 63, wave = tid >> 6;
    const int gw = obid() * NWAVES + wave, NGW = G * NWAVES;
    const bf16_t* xb = (const bf16_t*)(p.ws + WS_XB);
    f32x4 gv[4];
#pragma unroll
    for (int j = 0; j < 4; ++j) gv[j] = ((const f32x4*)p.final_g)[lane + 64 * j];
    for (int m = gw; m < M; m += NGW) {
        const u32x2* xr = (const u32x2*)(xb + (size_t)m * DM) + lane;
        f32x4* orow = (f32x4*)(p.out + (size_t)m * DM) + lane;
        f32x4 v[4]; float s = 0.f;
#pragma unroll
        for (int j = 0; j < 4; ++j) { const u32x2 w = xr[64 * j]; v[j] = (f32x4){bflo(w.x), bfhi(w.x), bflo(w.y), bfhi(w.y)}; s += (v[j].x * v[j].x + v[j].y * v[j].y) + (v[j].z * v[j].z + v[j].w * v[j].w); }
        const float rs = rsqrtf(wave_sum(s) * (1.f / DM) + EPS);
#pragma unroll
        for (int j = 0; j < 4; ++j) orow[64 * j] = v[j] * rs * gv[j];
    }
}

#define XB_TMO      128
#define XB_XCNT(j)  (256  + 64 * (j))
#define XB_XSUB(j)  (1280 + 64 * (j))
#define XB_XGEN(j)  (2304 + 64 * (j))
#define XB_TOP      3328
#define XB_TOPGEN   3392
#define XCD_BAR_WORDS 3456
#define XB_SPIN_CAP (1u << 18)
__device__ __forceinline__ unsigned xb_ld(unsigned* p)              { return __hip_atomic_load(p, __ATOMIC_RELAXED, __HIP_MEMORY_SCOPE_AGENT); }
__device__ __forceinline__ unsigned xb_add(unsigned* p, unsigned v) { return __hip_atomic_fetch_add(p, v, __ATOMIC_RELAXED, __HIP_MEMORY_SCOPE_AGENT); }
__device__ __forceinline__ unsigned xb_xcc_id() { return (unsigned)__builtin_amdgcn_s_getreg((3 << 11) | 20) & 0xFu; }
#define XB_SPIN(cond, bar) do { unsigned _sp = 0; while (cond) { __builtin_amdgcn_s_sleep(1); \
    if ((++_sp & 255u) == 0u) { if (xb_ld(&(bar)[XB_TMO])) break; if (_sp > XB_SPIN_CAP) { atomicAdd(&(bar)[XB_TMO], 1u); break; } } } } while (0)
struct XcdBarrier { unsigned* bar; unsigned x; volatile LAS unsigned* st; };
__device__ __forceinline__ XcdBarrier xcd_barrier_post(unsigned* bar, volatile LAS unsigned* st) {
    XcdBarrier b; b.bar = bar; b.x = xb_xcc_id(); b.st = st;
    if (threadIdx.x == 0) (void)xb_add(&bar[XB_XCNT(b.x)], 1u);
    return b;
}
__device__ __forceinline__ void xcd_barrier_complete(unsigned* bar, unsigned x, unsigned& nloc, unsigned& nx) {
    const unsigned G = gridDim.x * gridDim.y * gridDim.z;
    unsigned sum, cnt, mine, sp = 0u;
    for (;;) {
        sum = 0u; cnt = 0u; mine = 0u;
#pragma unroll
        for (unsigned j = 0; j < 16; ++j) { const unsigned c = xb_ld(&bar[XB_XCNT(j)]); sum += c; cnt += (c > 0u) ? 1u : 0u; mine = (j == x) ? c : mine; }
        if (sum == G) break;
        __builtin_amdgcn_s_sleep(1);
        if ((++sp & 255u) == 0u) { if (xb_ld(&bar[XB_TMO])) break; if (sp > XB_SPIN_CAP) { atomicAdd(&bar[XB_TMO], 1u); break; } }
    }
    nloc = mine > 0u ? mine : 1u; nx = cnt > 0u ? cnt : 1u;
}
__device__ __forceinline__ void xcd_barrier(const XcdBarrier& b) {
    asm volatile("s_waitcnt vmcnt(0)" ::: "memory");
    __syncthreads();
    if (threadIdx.x == 0) {
        unsigned* bar = b.bar;
        __builtin_amdgcn_s_waitcnt(0);
        unsigned nloc = b.st[0], nx = b.st[1];
        if (nloc == 0u) { xcd_barrier_complete(bar, b.x, nloc, nx); b.st[0] = nloc; b.st[1] = nx; }
        const unsigned old = xb_add(&bar[XB_XSUB(b.x)], 1u);
        const unsigned gen = old / nloc;
        if (old + 1u == (gen + 1u) * nloc) {
            __builtin_amdgcn_fence(__ATOMIC_RELEASE, "agent");
            asm volatile("s_waitcnt vmcnt(0)" ::: "memory");
            const unsigned og = xb_add(&bar[XB_TOP], 1u);
            const unsigned tg = og / nx;
            if (og + 1u == (tg + 1u) * nx) xb_add(&bar[XB_TOPGEN], 1u);
            else XB_SPIN(xb_ld(&bar[XB_TOPGEN]) == tg, bar);
            __builtin_amdgcn_fence(__ATOMIC_ACQUIRE, "agent");
            xb_add(&bar[XB_XGEN(b.x)], 1u);
            asm volatile("s_waitcnt vmcnt(0)" ::: "memory");
        } else {
            XB_SPIN(xb_ld(&bar[XB_XGEN(b.x)]) == gen, bar);
            __builtin_amdgcn_fence(__ATOMIC_ACQUIRE, "agent");
            asm volatile("s_waitcnt vmcnt(0)" ::: "memory");
        }
    }
    __syncthreads();
}

__global__ void __launch_bounds__(NWAVES * 64, 2) hybrid_fwd(Params p) {
    extern __shared__ __attribute__((aligned(16))) unsigned char lds_raw[];
    LAS unsigned char* lds = (LAS unsigned char*)lds_raw;
    cg::grid_group grid = cg::this_grid();
    const int G = gridDim.x;
    unsigned char* ws = p.ws;
    bf16_t* xb = (bf16_t*)(ws + WS_XB); bf16_t* act = (bf16_t*)(ws + WS_ACT); bf16_t* cat = (bf16_t*)(ws + WS_CAT);
    float* ssq = (float*)(ws + WS_SSQ);
    LAS float* tbl = (LAS float*)(lds + TBL_OFF);

    volatile LAS unsigned* misc = (volatile LAS unsigned*)(lds + MISC_OFF);
    if (threadIdx.x < 2) misc[threadIdx.x] = 0u;
    __syncthreads();
    const XcdBarrier xbar = xcd_barrier_post((unsigned*)(ws + WS_CTL), misc);
    prologue_phase(p, lds, G);
    grid.sync();

    int np = 16;
    const float* base = p.x;
#pragma unroll 1
    for (int layer = 0; layer < DEPTH; ++layer) {
#pragma unroll 1
        for (int j = 0; j < 2; ++j) {
            const int mi = layer * 2 + j;
            {
                pg8::Gemm g{xb, (const bf16_t*)(ws + WS_WFFN_IN + mi * SZ_WFFN_IN), M, 2 * DFF, DM};
                pg8::StaticOrder S; S.init(M, 2 * DFF, G, obid());
                EpiSwiglu E{act, RsTable{ssq, np, tbl}};
                pg8::gemm_phase<EpiSwiglu>(lds, g, S, E);
            }
            xcd_barrier(xbar);
            {
                pg8::Gemm g{act, (const bf16_t*)(ws + WS_WFFN_OUT + mi * SZ_WFFN_OUT), M, DM, DFF};
                pg8::StaticOrder S; S.init(M, DM, G, obid());
                EpiResid E{base, xb, ssq, 0.5f};
                pg8::gemm_phase<EpiResid>(lds, g, S, E);
            }
            base = nullptr; np = 16;
            xcd_barrier(xbar);
            if (j == 0) {
                if ((layer & 1) == 0) {
                    const int e = layer >> 1;
                    {
                        pg8::Gemm g{xb, (const bf16_t*)(ws + WS_WMIX_IN + e * SZ_WMIX_IN), M, MIXIN, DM};
                        pg8::StaticOrder S; S.init(M, MIXIN, G, obid());
                        EpiMixIn E{act, (float*)(ws + WS_F), (float*)(ws + WS_QS), p.hgrn_lb, e, RsTable{ssq, np, tbl}};
                        pg8::gemm_phase<EpiMixIn>(lds, g, S, E);
                    }
                    xcd_barrier(xbar);
                    for (int it = obid(); it < 256; it += G) hgrn_mma<false>(p, it, lds);
                    attn_mma(p, e, lds, G);
                    xcd_barrier(xbar);
                    for (int it = obid(); it < 256; it += G) hgrn_mma<true>(p, it, lds);
                    xcd_barrier(xbar);
                    {
                        pg8::Gemm g{cat, (const bf16_t*)(ws + WS_WMIX_OUT + e * SZ_WMIX_OUT), M, DM, DM};
                        pg8::StaticOrder S; S.init(M, DM, G, obid());
                        EpiResid E{base, xb, ssq, 1.0f};
                        pg8::gemm_phase<EpiResid>(lds, g, S, E);
                    }
                    np = 16;
                    xcd_barrier(xbar);
                } else {
                    const int oi = layer >> 1;
                    s5_phase(p, layer, oi, lds, G);
                    xcd_barrier(xbar);
                    {
                        pg8::Gemm g{cat, (const bf16_t*)(ws + WS_WGLU + oi * SZ_WGLU), M, 2 * DM, DM};
                        pg8::StaticOrder S; S.init(M, 2 * DM, G, obid());
                        EpiGlu E{xb, ssq};
                        pg8::gemm_phase<EpiGlu>(lds, g, S, E);
                    }
                    np = 32;
                    xcd_barrier(xbar);
                }
            }
        }
    }
    final_norm(p, G);
}

extern "C" void kernel_launch(void* const* d_in, const int* in_sizes, int n_in, void* d_out, int out_size, void* d_ws, size_t ws_size, hipStream_t stream) {
    static int grid = 0;
    if (grid == 0) {
        if (n_in != 18 || in_sizes[0] != M * DM || out_size != M * DM || ws_size < WS_END) {
            fprintf(stderr, "kernel_launch: unexpected shapes: n_in %d in0 %d out %d ws %zu (need %zu)\n", n_in, n_in > 0 ? in_sizes[0] : -1, out_size, ws_size, (size_t)WS_END); grid = -1; return; }
        int dev = 0, cus = 0, per_cu = 0;
        hipGetDevice(&dev);
        hipDeviceGetAttribute(&cus, hipDeviceAttributeMultiprocessorCount, dev);
        if (hipFuncSetAttribute((const void*)hybrid_fwd, hipFuncAttributeMaxDynamicSharedMemorySize, LDS_BYTES) != hipSuccess) { fprintf(stderr, "kernel_launch: hipFuncSetAttribute failed\n"); grid = -1; return; }
        if (hipOccupancyMaxActiveBlocksPerMultiprocessor(&per_cu, (const void*)hybrid_fwd, NWAVES * 64, LDS_BYTES) != hipSuccess || per_cu < 1) { fprintf(stderr, "kernel_launch: occupancy query gave %d\n", per_cu); per_cu = 1; }
        (void)hipGetLastError();
        grid = cus * per_cu;
    }
    if (grid < 0) return;
    if (hipMemsetAsync((char*)d_ws + WS_CTL, 0, CTL_BYTES, stream) != hipSuccess) { fprintf(stderr, "kernel_launch: memset of barrier words failed\n"); return; }
    Params p{};
    const float** pp = (const float**)&p;
    for (int i = 0; i < 18; ++i) pp[i] = (const float*)d_in[i];
    p.out = (float*)d_out; p.ws = (unsigned char*)d_ws;
    void* args[] = {&p};
    hipError_t e = hipLaunchCooperativeKernel((const void*)hybrid_fwd, dim3(grid), dim3(NWAVES * 64), args, LDS_BYTES, stream);
    if (e != hipSuccess) fprintf(stderr, "cooperative launch failed: %s (grid %d)\n", hipGetErrorString(e), grid);
}
```

```cpp
#include <hip/hip_runtime.h>
#include <hip/hip_cooperative_groups.h>
#include <cstdio>
#include <cstdint>
namespace cg = cooperative_groups;

#define LAS __attribute__((address_space(3)))
typedef unsigned short bf16_t;
typedef short bf16x8 __attribute__((ext_vector_type(8)));
typedef float f32x4 __attribute__((ext_vector_type(4)));
typedef float f32x2 __attribute__((ext_vector_type(2)));
typedef unsigned u32x4 __attribute__((ext_vector_type(4)));
typedef unsigned u32x2 __attribute__((ext_vector_type(2)));

constexpr int BATCH = 4, SEQ = 8192, DM = 1024, DEPTH = 4, DFF = 2816;
constexpr int M = BATCH * SEQ;
constexpr int MIXIN = 2816;
constexpr float EPS = 1e-6f;
constexpr int NWAVES = 8;

constexpr size_t SZ_WFFN_IN = (size_t)2 * DFF * DM * 2;
constexpr size_t SZ_WFFN_OUT = (size_t)DM * DFF * 2;
constexpr size_t SZ_WMIX_IN = (size_t)MIXIN * DM * 2;
constexpr size_t SZ_WMIX_OUT = (size_t)DM * DM * 2;
constexpr size_t SZ_WGLU = (size_t)2 * DM * DM * 2;
constexpr size_t WS_WFFN_IN = 0;
constexpr size_t WS_WFFN_OUT = WS_WFFN_IN + 8 * SZ_WFFN_IN;
constexpr size_t WS_WMIX_IN = WS_WFFN_OUT + 8 * SZ_WFFN_OUT;
constexpr size_t WS_WMIX_OUT = WS_WMIX_IN + 2 * SZ_WMIX_IN;
constexpr size_t WS_WGLU = WS_WMIX_OUT + 2 * SZ_WMIX_OUT;
constexpr size_t WS_XB = WS_WGLU + 2 * SZ_WGLU;
constexpr size_t WS_ACT = WS_XB + (size_t)M * DM * 2;
constexpr size_t WS_CAT = WS_ACT + (size_t)M * DFF * 2;
constexpr size_t WS_SSQ = WS_CAT + (size_t)M * DM * 2;
constexpr size_t WS_F = WS_SSQ + (size_t)M * 32 * 4;
constexpr size_t WS_QS = WS_F + (size_t)M * 512 * 4;
constexpr size_t WS_OB = WS_QS + (size_t)M * 512 * 4;
constexpr int HNS = 16, HSEG = SEQ / HNS;
constexpr size_t WS_HS = WS_OB + (size_t)M * 512 * 4;
constexpr size_t WS_HD = WS_HS + (size_t)256 * 512 * 32 * 4;
constexpr size_t WS_CTL = WS_HD + (size_t)256 * 512 * 8 * 4;
constexpr size_t CTL_BYTES = 16384;
constexpr size_t WS_END = WS_CTL + CTL_BYTES;

constexpr int RING_BYTES = 131072;
constexpr int TBL_OFF = RING_BYTES;
constexpr int MISC_OFF = RING_BYTES + 12288;
constexpr int LDS_BYTES = 147456;

__device__ __forceinline__ int otid() { int t = threadIdx.x; asm volatile("" : "+v"(t)); return t; }
__device__ __forceinline__ int obid() { int b = blockIdx.x; asm volatile("" : "+s"(b)); return b; }
template <class T> __device__ __forceinline__ T* optr(T* p) { asm volatile("" : "+s"(p)); return p; }
typedef __bf16 bf16x2_t __attribute__((ext_vector_type(2)));
__device__ __forceinline__ unsigned cvt_pk_bf16(float lo, float hi) { const f32x2 v = {lo, hi}; const bf16x2_t b = __builtin_convertvector(v, bf16x2_t); return __builtin_bit_cast(unsigned, b); }
__device__ __forceinline__ float bf2f(unsigned short h) { return __uint_as_float(((unsigned)h) << 16); }
__device__ __forceinline__ float bflo(unsigned w) { return __uint_as_float(w << 16); }
__device__ __forceinline__ float bfhi(unsigned w) { return __uint_as_float(w & 0xffff0000u); }
__device__ __forceinline__ float fast_rcp(float x) { return __builtin_amdgcn_rcpf(x); }
__device__ __forceinline__ float sigmoidf_(float x) { return fast_rcp(1.f + __expf(-x)); }
__device__ __forceinline__ float siluf_(float x) { return x * sigmoidf_(x); }
__device__ __forceinline__ float wave_sum(float v) {
#pragma unroll
    for (int o = 1; o < 64; o <<= 1) v += __shfl_xor(v, o);
    return v;
}
__device__ __forceinline__ void store16_wt(void* p, u32x4 v) { asm volatile("global_store_dwordx4 %0, %1, off sc1" :: "v"(p), "v"(v) : "memory"); }
__device__ __forceinline__ float gelu_tanh(float v) {
    const float u = 0.7978845608028654f * (v + 0.044715f * v * v * v);
    const float t = 1.f - 2.f * fast_rcp(1.f + __expf(2.f * u));
    return 0.5f * v * (1.f + t);
}

struct RsRegs { f32x4 v[4]; };
namespace pg8 {
constexpr int BM = 256, BK = 64, HALF = 128, HTB = HALF * BK * 2, STAGE_BYTES = 8 * HTB, NXCD = 8, WGM = 8;
__device__ __forceinline__ int lds_byte(int r, int c) { const int st = (r >> 4) * 2 + (c >> 5), rr = r & 15, cc = c & 31, ob = rr * 64 + cc * 2; return st * 1024 + (ob ^ (((ob >> 9) & 1) << 5)); }
__device__ __forceinline__ void stage_rc(int b, int& R, int& C) { const int st = b / 1024, sb = b % 1024, swz = sb ^ (((sb >> 9) & 1) << 5); R = (st >> 1) * 16 + swz / 64; C = (st & 1) * 32 + (swz % 64) / 2; }
__device__ __forceinline__ int perm32(int rho) { const int n = rho >> 4, i = rho & 15; return 8 * (i >> 2) + 4 * n + (i & 3); }

struct Unit { int pm, pn; };
struct Gemm { const bf16_t* A; const bf16_t* Bt; int M, N, K; };

struct StaticOrder {
    int nM, nN, nwg, G, c;
    __device__ void init(int M_, int N_, int G_, int c_) { nM = M_ / BM; nN = N_ / BM; nwg = nM * nN; G = G_; c = c_; }
    __device__ bool next(int i, Unit& u) const {
        const long L = (long)i * G + c; if (L >= nwg) return false;
        int wgid = (int)L; { const int q = nwg / NXCD, r = nwg % NXCD, xcd = wgid % NXCD, off = wgid / NXCD; wgid = (xcd < r ? xcd * (q + 1) : r * (q + 1) + (xcd - r) * q) + off; }
        const int nig = WGM * nN, gid = wgid / nig, fm = gid * WGM, gsz = (nM - fm) < WGM ? (nM - fm) : WGM;
        u.pm = fm + ((wgid % nig) % gsz); u.pn = (wgid % nig) / gsz; return true;
    }
};

template <class Epi>
__device__ __forceinline__ void gemm_phase(LAS unsigned char* lds, const Gemm g, const StaticOrder& S, const Epi& E) {
    const int tid = otid(), wid = __builtin_amdgcn_readfirstlane(tid >> 6), lane = tid & 63, wr = wid >> 2, wc = wid & 3, fr = lane & 15, fq = lane >> 4;
    const int K = g.K, nt = K / BK;
    const char* gA = (const char*)optr(g.A); const char* gB = (const char*)optr(g.Bt);
    unsigned voffA[2], voffB[2];
#pragma unroll
    for (int i = 0; i < 2; ++i) { int R, C; stage_rc(tid * 16 + i * 8192, R, C); const int Rb = Epi::PERM ? ((R & ~31) + perm32(R & 31)) : R;
        voffA[i] = (unsigned)(R * K + C) * 2u; voffB[i] = (unsigned)(Rb * K + C) * 2u; }
    const size_t kstep = (size_t)(BK * 2);
    const size_t hstep = (size_t)HALF * K * 2;
    const size_t tstep = 2 * hstep;
    const unsigned ldsw = (unsigned)wid * 1024u;
    const int aoff = lds_byte(wr * 64 + fr, fq * 8), boff = lds_byte(wc * 32 + fr, fq * 8);
#define PG8_SA(b, h) (((b) * 2 + (h)) * HTB)
#define PG8_SB(b, h) ((4 + (b) * 2 + (h)) * HTB)
#define PG8_STAGE(bufoff, gbase, voff) do { _Pragma("unroll") for (int _i = 0; _i < 2; ++_i) \
        __builtin_amdgcn_global_load_lds((const unsigned*)((const char*)(gbase) + (voff)[_i]), (LAS unsigned*)(lds + (bufoff) + ldsw + _i * 8192), 16, 0, 0); } while (0)
#define PG8_LDA(dst, b, h) do { _Pragma("unroll") for (int m = 0; m < 4; ++m) _Pragma("unroll") for (int k = 0; k < 2; ++k) dst[m][k] = *(const LAS bf16x8*)(lds + PG8_SA(b, h) + aoff + m * 2048 + k * 1024); } while (0)
#define PG8_LDB(dst, b, h) do { _Pragma("unroll") for (int n = 0; n < 2; ++n) _Pragma("unroll") for (int k = 0; k < 2; ++k) dst[n][k] = *(const LAS bf16x8*)(lds + PG8_SB(b, h) + boff + n * 2048 + k * 1024); } while (0)
#define PG8_MMA(ai, bj, At, Bt) do { __builtin_amdgcn_s_setprio(1); _Pragma("unroll") for (int m = 0; m < 4; ++m) _Pragma("unroll") for (int n = 0; n < 2; ++n) _Pragma("unroll") for (int k = 0; k < 2; ++k) \
        acc[ai][bj][m][n] = __builtin_amdgcn_mfma_f32_16x16x32_bf16(Bt[n][k], At[m][k], acc[ai][bj][m][n], 0, 0, 0); __builtin_amdgcn_s_setprio(0); } while (0)
#define PG8_WAIT_V(n) asm volatile("s_waitcnt vmcnt(" #n ")" ::: "memory")
#define PG8_WAIT_L(n) asm volatile("s_waitcnt lgkmcnt(" #n ")" ::: "memory")
#define PG8_BAR __builtin_amdgcn_s_barrier()
#define PG8_SCHED __builtin_amdgcn_sched_barrier(0)
    Unit cur, nxt; int ui = 0;
    if (!S.next(0, cur)) return;
    f32x4 acc[2][2][4][2];
#pragma unroll
    for (int a = 0; a < 2; ++a)
#pragma unroll
        for (int b = 0; b < 2; ++b)
#pragma unroll
            for (int m = 0; m < 4; ++m)
#pragma unroll
                for (int n = 0; n < 2; ++n) acc[a][b][m][n] = (f32x4){0.f, 0.f, 0.f, 0.f};
    bf16x8 At[4][2], B0[2][2], B1[2][2];
    const char* cA = gA + (size_t)cur.pm * tstep; const char* cB = gB + (size_t)cur.pn * tstep;
    RsRegs rsr; E.issue(cur, rsr); E.commit(0, rsr);
    int tsel = 0;
    PG8_STAGE(PG8_SB(0, 0), cB, voffB); PG8_STAGE(PG8_SB(0, 1), cB + hstep, voffB); PG8_STAGE(PG8_SA(0, 0), cA, voffA); PG8_STAGE(PG8_SA(0, 1), cA + hstep, voffA);
    if (wr == 1) PG8_BAR;
    PG8_WAIT_V(2); PG8_BAR;
    PG8_STAGE(PG8_SB(1, 0), cB + kstep, voffB); PG8_STAGE(PG8_SA(1, 0), cA + kstep, voffA); PG8_STAGE(PG8_SB(1, 1), cB + hstep + kstep, voffB);
    PG8_WAIT_V(6); PG8_BAR;
    for (;;) {
        const bool has_next = S.next(ui + 1, nxt);
        const char* nA = has_next ? gA + (size_t)nxt.pm * tstep : cA; const char* nB = has_next ? gB + (size_t)nxt.pn * tstep : cB;
        for (int t = 0; t < nt; t += 2) {
            const bool last = (t == nt - 2);
            const char* a1 = cA + (size_t)(t + 1) * kstep;
            const char* a2 = last ? nA : cA + (size_t)(t + 2) * kstep; const char* b2 = last ? nB : cB + (size_t)(t + 2) * kstep;
            const char* a3 = a2 + kstep; const char* b3 = b2 + kstep;
            const int strict = __builtin_amdgcn_readfirstlane(((t == 0) && (ui > 0)) ? 0 : 1);
#define PG8_WAIT_V8R asm volatile("s_waitcnt vmcnt(16)\n\ts_cmp_eq_u32 %0, 0\n\ts_cbranch_scc1 1f\n\ts_waitcnt vmcnt(8)\n1:" :: "s"(strict) : "scc", "memory")
            PG8_LDB(B0, 0, 0); PG8_LDB(B1, 0, 1); PG8_SCHED; PG8_LDA(At, 0, 0); PG8_STAGE(PG8_SA(1, 1), a1 + hstep, voffA);
            PG8_WAIT_V8R;
            PG8_WAIT_L(0); PG8_BAR; PG8_MMA(0, 0, At, B0); PG8_MMA(0, 1, At, B1); PG8_BAR; PG8_SCHED;
            PG8_LDA(At, 0, 1); PG8_STAGE(PG8_SB(0, 0), b2, voffB); PG8_STAGE(PG8_SB(0, 1), b2 + hstep, voffB); PG8_STAGE(PG8_SA(0, 0), a2, voffA);
            PG8_WAIT_V8R;
            PG8_WAIT_L(0); PG8_BAR; PG8_MMA(1, 0, At, B0); PG8_MMA(1, 1, At, B1); PG8_BAR; PG8_SCHED;
            PG8_LDB(B0, 1, 0); PG8_LDB(B1, 1, 1); PG8_SCHED; PG8_LDA(At, 1, 0); PG8_STAGE(PG8_SA(0, 1), a2 + hstep, voffA);
            PG8_WAIT_V(8); PG8_WAIT_L(0); PG8_BAR; PG8_MMA(0, 0, At, B0); PG8_MMA(0, 1, At, B1); PG8_BAR; PG8_SCHED;
            PG8_LDA(At, 1, 1); PG8_STAGE(PG8_SB(1, 0), b3, voffB); PG8_STAGE(PG8_SB(1, 1), b3 + hstep, voffB); PG8_STAGE(PG8_SA(1, 0), a3, voffA);
            PG8_WAIT_V(8); PG8_WAIT_L(0); PG8_BAR; PG8_MMA(1, 0, At, B0); PG8_MMA(1, 1, At, B1); PG8_BAR; PG8_SCHED;
        }
        if (wr == 0) PG8_BAR;
        const bool newpm = has_next && (nxt.pm != cur.pm);
        if (newpm) E.issue(nxt, rsr);
        E(acc, cur, tsel, wr, wc, fr, fq);
        if (!has_next) break;
#pragma unroll
        for (int a = 0; a < 2; ++a)
#pragma unroll
            for (int b = 0; b < 2; ++b)
#pragma unroll
                for (int m = 0; m < 4; ++m)
#pragma unroll
                    for (int n = 0; n < 2; ++n) acc[a][b][m][n] = (f32x4){0.f, 0.f, 0.f, 0.f};
        cur = nxt; cA = nA; cB = nB; ++ui;
        if (newpm) { tsel ^= 1; E.commit(tsel, rsr); }
        if (wr == 1) PG8_BAR;
    }
    PG8_WAIT_V(0);
    PG8_BAR;
#undef PG8_SA
#undef PG8_SB
#undef PG8_STAGE
#undef PG8_LDA
#undef PG8_LDB
#undef PG8_MMA
#undef PG8_WAIT_V
#undef PG8_WAIT_V8R
#undef PG8_WAIT_L
#undef PG8_BAR
#undef PG8_SCHED
}
}
using pg8::Unit;

struct RsTable {
    const float* ssq; int np; LAS float* tbl;
    __device__ __forceinline__ void issue(const Unit& u, RsRegs& R) const {
        const int t = otid(), row = t >> 1, half = t & 1, hn = np >> 1;
        const float* p = ssq + (size_t)(u.pm * 256 + row) * 32 + half * hn;
        R.v[0] = *(const f32x4*)p; R.v[1] = *(const f32x4*)(p + 4);
        if (hn > 8) { R.v[2] = *(const f32x4*)(p + 8); R.v[3] = *(const f32x4*)(p + 12); } else { R.v[2] = (f32x4){0.f, 0.f, 0.f, 0.f}; R.v[3] = R.v[2]; }
    }
    __device__ __forceinline__ void commit(int ui, const RsRegs& R) const {
        const int t = otid(), row = t >> 1, half = t & 1;
        const f32x4 a = (R.v[0] + R.v[1]) + (R.v[2] + R.v[3]);
        float s = (a.x + a.y) + (a.z + a.w);
        s += __shfl_xor(s, 1);
        if (!half) tbl[(ui & 1) * 256 + row] = rsqrtf(s * (1.f / DM) + EPS);
    }
};

struct EpiSwiglu {
    static constexpr bool PERM = true;
    bf16_t* O; RsTable rt;
    __device__ __forceinline__ void issue(const Unit& u, RsRegs& R) const { rt.issue(u, R); }
    __device__ __forceinline__ void commit(int ui, const RsRegs& R) const { rt.commit(ui, R); }
    __device__ __forceinline__ void operator()(const f32x4 (&acc)[2][2][4][2], const Unit& u, int ui, int wr, int wc, int fr, int fq) const {
        const LAS float* tb = rt.tbl + (ui & 1) * 256;
        const int col0 = u.pn * 128 + wc * 32 + 8 * fq;
#pragma unroll
        for (int ai = 0; ai < 2; ++ai)
#pragma unroll
            for (int m = 0; m < 4; ++m) {
                const int r = ai * 128 + wr * 64 + m * 16 + fr; const float rs = tb[r];
                const float nrl = -1.4426950408889634f * rs, rs2 = rs * rs;
                float o[8];
#pragma unroll
                for (int n = 0; n < 2; ++n)
#pragma unroll
                    for (int j = 0; j < 4; ++j) { const float ag = acc[ai][0][m][n][j], au = acc[ai][1][m][n][j];
                        const float e = __builtin_amdgcn_exp2f(ag * nrl);
                        o[n * 4 + j] = (ag * au) * (fast_rcp(1.f + e) * rs2); }
                u32x4 w; w.x = cvt_pk_bf16(o[0], o[1]); w.y = cvt_pk_bf16(o[2], o[3]); w.z = cvt_pk_bf16(o[4], o[5]); w.w = cvt_pk_bf16(o[6], o[7]);
                store16_wt(O + (size_t)(u.pm * 256 + r) * DFF + col0, w);
            }
    }
};

struct EpiMixIn {
    static constexpr bool PERM = true;
    bf16_t* P; float* F; float* QS; const float* lbraw; int e; RsTable rt;
    __device__ __forceinline__ void issue(const Unit& u, RsRegs& R) const { rt.issue(u, R); }
    __device__ __forceinline__ void commit(int ui, const RsRegs& R) const { rt.commit(ui, R); }
    __device__ __forceinline__ void operator()(const f32x4 (&acc)[2][2][4][2], const Unit& u, int ui, int wr, int wc, int fr, int fq) const {
        const LAS float* tb = rt.tbl + (ui & 1) * 256;
        const int mode = (u.pn == 5 || u.pn == 6) ? 1 : ((u.pn == 3 || u.pn == 4) ? 2 : 0);
#pragma unroll
        for (int bj = 0; bj < 2; ++bj) {
            const int col0 = u.pn * 256 + bj * 128 + wc * 32 + 8 * fq;
            float lb[8];
#pragma unroll
            for (int j = 0; j < 8; ++j) lb[j] = 0.f;
            if (mode == 1 && e == 1) {
#pragma unroll
                for (int j = 0; j < 8; ++j) { const int c = col0 - 1280 + j; lb[j] = fast_rcp(1.f + __expf(lbraw[c] - lbraw[512 + c])); }
            }
#pragma unroll
            for (int ai = 0; ai < 2; ++ai)
#pragma unroll
                for (int m = 0; m < 4; ++m) {
                    const int r = ai * 128 + wr * 64 + m * 16 + fr; const float rs = tb[r]; const size_t row = (size_t)(u.pm * 256 + r);
                    float v[8];
#pragma unroll
                    for (int n = 0; n < 2; ++n)
#pragma unroll
                        for (int j = 0; j < 4; ++j) v[n * 4 + j] = acc[ai][bj][m][n][j] * rs;
                    if (mode == 0) {
                        u32x4 w; w.x = cvt_pk_bf16(v[0], v[1]); w.y = cvt_pk_bf16(v[2], v[3]); w.z = cvt_pk_bf16(v[4], v[5]); w.w = cvt_pk_bf16(v[6], v[7]);
                        *(u32x4*)(P + row * MIXIN + col0) = w;
                    } else if (mode == 1) {
#pragma unroll
                        for (int j = 0; j < 8; ++j) v[j] = lb[j] + (1.f - lb[j]) * sigmoidf_(v[j]);
                        float* d = F + row * 512 + (col0 - 1280);
                        *(f32x4*)d = (f32x4){v[0], v[1], v[2], v[3]}; *(f32x4*)(d + 4) = (f32x4){v[4], v[5], v[6], v[7]};
                    } else {
#pragma unroll
                        for (int j = 0; j < 8; ++j) v[j] = siluf_(v[j]);
                        float* d = QS + row * 512 + (col0 - 768);
                        *(f32x4*)d = (f32x4){v[0], v[1], v[2], v[3]}; *(f32x4*)(d + 4) = (f32x4){v[4], v[5], v[6], v[7]};
                    }
                }
        }
    }
};

struct EpiResid {
    static constexpr bool PERM = true;
    const float* base32; bf16_t* xb; float* ssq; float alpha;
    __device__ __forceinline__ void issue(const Unit&, RsRegs&) const {}
    __device__ __forceinline__ void commit(int, const RsRegs&) const {}
    __device__ __forceinline__ void operator()(const f32x4 (&acc)[2][2][4][2], const Unit& u, int ui, int wr, int wc, int fr, int fq) const {
        const int col0 = u.pn * 256 + wc * 32 + 8 * fq;
#pragma unroll
        for (int ai = 0; ai < 2; ++ai)
#pragma unroll
            for (int m = 0; m < 4; ++m) {
                const size_t row = (size_t)(u.pm * 256 + ai * 128 + wr * 64 + m * 16 + fr); const size_t off = row * DM + col0;
                f32x4 bs[2][2];
                if (base32) {
#pragma unroll
                    for (int bj = 0; bj < 2; ++bj)
#pragma unroll
                        for (int n = 0; n < 2; ++n) bs[bj][n] = *(const f32x4*)(base32 + off + bj * 128 + n * 4);
                } else {
#pragma unroll
                    for (int bj = 0; bj < 2; ++bj) { const u32x4 w = *(const u32x4*)(xb + off + bj * 128);
                        bs[bj][0] = (f32x4){bflo(w.x), bfhi(w.x), bflo(w.y), bfhi(w.y)}; bs[bj][1] = (f32x4){bflo(w.z), bfhi(w.z), bflo(w.w), bfhi(w.w)}; }
                }
                float s = 0.f;
#pragma unroll
                for (int bj = 0; bj < 2; ++bj) {
                    const f32x4 o0 = bs[bj][0] + acc[ai][bj][m][0] * alpha, o1 = bs[bj][1] + acc[ai][bj][m][1] * alpha;
                    u32x4 w; w.x = cvt_pk_bf16(o0[0], o0[1]); w.y = cvt_pk_bf16(o0[2], o0[3]); w.z = cvt_pk_bf16(o1[0], o1[1]); w.w = cvt_pk_bf16(o1[2], o1[3]);
                    *(u32x4*)(xb + off + bj * 128) = w;
                    s += ((o0[0] * o0[0] + o0[1] * o0[1]) + (o0[2] * o0[2] + o0[3] * o0[3])) + ((o1[0] * o1[0] + o1[1] * o1[1]) + (o1[2] * o1[2] + o1[3] * o1[3]));
                }
                s += __shfl_xor(s, 16); s += __shfl_xor(s, 32);
                if (fq == 0) ssq[row * 32 + u.pn * 4 + wc] = s;
                asm volatile("" ::: "memory");
            }
    }
};

struct EpiGlu {
    static constexpr bool PERM = true;
    bf16_t* xb; float* ssq;
    __device__ __forceinline__ void issue(const Unit&, RsRegs&) const {}
    __device__ __forceinline__ void commit(int, const RsRegs&) const {}
    __device__ __forceinline__ void operator()(const f32x4 (&acc)[2][2][4][2], const Unit& u, int ui, int wr, int wc, int fr, int fq) const {
        const int col0 = u.pn * 128 + wc * 32 + 8 * fq;
#pragma unroll
        for (int ai = 0; ai < 2; ++ai)
#pragma unroll
            for (int m = 0; m < 4; ++m) {
                const size_t row = (size_t)(u.pm * 256 + ai * 128 + wr * 64 + m * 16 + fr); const size_t off = row * DM + col0;
                const u32x4 bw = *(const u32x4*)(xb + off);
                const float b[8] = {bflo(bw.x), bfhi(bw.x), bflo(bw.y), bfhi(bw.y), bflo(bw.z), bfhi(bw.z), bflo(bw.w), bfhi(bw.w)};
                float o[8]; float s = 0.f;
#pragma unroll
                for (int n = 0; n < 2; ++n)
#pragma unroll
                    for (int j = 0; j < 4; ++j) { o[n * 4 + j] = b[n * 4 + j] + acc[ai][0][m][n][j] * sigmoidf_(acc[ai][1][m][n][j]); s += o[n * 4 + j] * o[n * 4 + j]; }
                u32x4 w; w.x = cvt_pk_bf16(o[0], o[1]); w.y = cvt_pk_bf16(o[2], o[3]); w.z = cvt_pk_bf16(o[4], o[5]); w.w = cvt_pk_bf16(o[6], o[7]);
                *(u32x4*)(xb + off) = w;
                s += __shfl_xor(s, 16); s += __shfl_xor(s, 32);
                if (fq == 0) ssq[row * 32 + u.pn * 4 + wc] = s;
                asm volatile("" ::: "memory");
            }
    }
};

struct Params {
    const float *x, *norm_g, *ffn_w_in, *ffn_w_out, *mix_w_in, *attn_sinks, *hgrn_lb, *mix_w_out;
    const float *s5_a_re, *s5_a_im, *s5_log_step, *s5_b_re, *s5_b_im, *s5_c_re, *s5_c_im, *s5_d, *s5_w_glu, *final_g;
    float* out; unsigned char* ws;
};

struct TItem { const float* W; bf16_t* WT; const float* gs; int K, N, ileave, item; };
__device__ __forceinline__ void titem_load(const TItem& t, int lane, f32x4 (&w)[8], float (&gsc)[8]) {
    const int nblk = t.N / 32, kb = t.item / nblk, nb = t.item % nblk, k0 = 64 * kb, n0 = 32 * nb;
#pragma unroll
    for (int i = 0; i < 8; ++i) { const int kk = 8 * i + (lane >> 3); w[i] = *(const f32x4*)(t.W + (size_t)(k0 + kk) * t.N + n0 + 4 * (lane & 7)); gsc[i] = t.gs ? t.gs[k0 + kk] : 1.f; }
}
__device__ __forceinline__ void titem_process(const TItem& t, int lane, LAS float* scr, const f32x4 (&w)[8], const float (&gsc)[8]) {
    const int nblk = t.N / 32, kb = t.item / nblk, nb = t.item % nblk, k0 = 64 * kb, n0 = 32 * nb, K = t.K;
#pragma unroll
    for (int i = 0; i < 8; ++i) { const int kk = 8 * i + (lane >> 3); LAS float* d = scr + kk * 33 + 4 * (lane & 7); const f32x4 v = w[i] * gsc[i]; d[0] = v.x; d[1] = v.y; d[2] = v.z; d[3] = v.w; if ((i & 1) == 1) asm volatile("s_waitcnt lgkmcnt(0)" ::: "memory"); }
    asm volatile("s_waitcnt lgkmcnt(0)" ::: "memory");
    int d0 = n0;
    if (t.ileave) { const int half = t.N >> 1; d0 = (n0 < half) ? ((n0 >> 7) * 256 + (n0 & 127)) : (((n0 - half) >> 7) * 256 + 128 + ((n0 - half) & 127)); }
    const int c = lane & 7;
#pragma unroll
    for (int j = 0; j < 4; ++j) { const int n = (lane >> 3) + 8 * j; const LAS float* s = scr + (8 * c) * 33 + n;
        u32x4 o; o.x = cvt_pk_bf16(s[0 * 33], s[1 * 33]); o.y = cvt_pk_bf16(s[2 * 33], s[3 * 33]); o.z = cvt_pk_bf16(s[4 * 33], s[5 * 33]); o.w = cvt_pk_bf16(s[6 * 33], s[7 * 33]);
        *(u32x4*)(t.WT + (size_t)(d0 + n) * K + k0 + 8 * c) = o; }
    asm volatile("s_waitcnt lgkmcnt(0)" ::: "memory");
}
constexpr int I_FI = (DM / 64) * (2 * DFF / 32), I_FO = (DFF / 64) * (DM / 32), I_MI = (DM / 64) * (MIXIN / 32), I_MO = (DM / 64) * (DM / 32), I_GL = (DM / 64) * (2 * DM / 32);
constexpr int NITEMS = 8 * I_FI + 8 * I_FO + 2 * I_MI + 2 * I_MO + 2 * I_GL;
__device__ __forceinline__ TItem decode_item(const Params& p, int r) {
    unsigned char* ws = p.ws; TItem t;
    if (r < 8 * I_FI) { const int mi = r / I_FI, l = mi >> 1, j = mi & 1;
        t.W = p.ffn_w_in + (size_t)mi * DM * 2 * DFF; t.K = DM; t.N = 2 * DFF; t.WT = (bf16_t*)(ws + WS_WFFN_IN + mi * SZ_WFFN_IN); t.gs = p.norm_g + (size_t)(l * 3 + (j ? 2 : 0)) * DM; t.ileave = 1; t.item = r - mi * I_FI; return t; }
    r -= 8 * I_FI;
    if (r < 8 * I_FO) { const int mi = r / I_FO;
        t.W = p.ffn_w_out + (size_t)mi * DFF * DM; t.K = DFF; t.N = DM; t.WT = (bf16_t*)(ws + WS_WFFN_OUT + mi * SZ_WFFN_OUT); t.gs = nullptr; t.ileave = 0; t.item = r - mi * I_FO; return t; }
    r -= 8 * I_FO;
    if (r < 2 * I_MI) { const int mi = r / I_MI;
        t.W = p.mix_w_in + (size_t)mi * DM * MIXIN; t.K = DM; t.N = MIXIN; t.WT = (bf16_t*)(ws + WS_WMIX_IN + mi * SZ_WMIX_IN); t.gs = p.norm_g + (size_t)((2 * mi) * 3 + 1) * DM; t.ileave = 0; t.item = r - mi * I_MI; return t; }
    r -= 2 * I_MI;
    if (r < 2 * I_MO) { const int mi = r / I_MO;
        t.W = p.mix_w_out + (size_t)mi * DM * DM; t.K = DM; t.N = DM; t.WT = (bf16_t*)(ws + WS_WMIX_OUT + mi * SZ_WMIX_OUT); t.gs = nullptr; t.ileave = 0; t.item = r - mi * I_MO; return t; }
    r -= 2 * I_MO;
    { const int mi = r / I_GL;
        t.W = p.s5_w_glu + (size_t)mi * DM * 2 * DM; t.K = DM; t.N = 2 * DM; t.WT = (bf16_t*)(ws + WS_WGLU + mi * SZ_WGLU); t.gs = nullptr; t.ileave = 1; t.item = r - mi * I_GL; return t; }
}

__device__ __forceinline__ void prologue_phase(const Params& p, LAS unsigned char* lds, int G) {
    const int tid = otid(), lane = tid & 63, wave = __builtin_amdgcn_readfirstlane(tid >> 6);
    LAS float* scr = (LAS float*)(lds + wave * 16384);
    const int gw = obid() * NWAVES + wave, NGW = G * NWAVES;
    unsigned char* ws = p.ws;
    for (int it = gw; it < NITEMS; it += 2 * NGW) {
        const bool hb = it + NGW < NITEMS;
        const TItem a = decode_item(p, it), b = decode_item(p, hb ? it + NGW : it);
        f32x4 wa[8], wb[8]; float ga[8], gb[8];
        titem_load(a, lane, wa, ga); titem_load(b, lane, wb, gb);
        titem_process(a, lane, scr, wa, ga);
        if (hb) titem_process(b, lane, scr, wb, gb);
    }
    bf16_t* xb = (bf16_t*)(ws + WS_XB); float* ssq = (float*)(ws + WS_SSQ);
    for (int m = gw; m < M; m += 2 * NGW) {
        const int m2 = (m + NGW < M) ? (m + NGW) : m;
        const f32x4* xr0 = (const f32x4*)(p.x + (size_t)m * DM) + lane; const f32x4* xr1 = (const f32x4*)(p.x + (size_t)m2 * DM) + lane;
        f32x4 v0[4], v1[4]; float s0 = 0.f, s1 = 0.f;
#pragma unroll
        for (int j = 0; j < 4; ++j) { v0[j] = xr0[64 * j]; v1[j] = xr1[64 * j]; }
#pragma unroll
        for (int j = 0; j < 4; ++j) { s0 += (v0[j].x * v0[j].x + v0[j].y * v0[j].y) + (v0[j].z * v0[j].z + v0[j].w * v0[j].w); s1 += (v1[j].x * v1[j].x + v1[j].y * v1[j].y) + (v1[j].z * v1[j].z + v1[j].w * v1[j].w); }
        s0 = wave_sum(s0); s1 = wave_sum(s1);
        u32x2* o0 = (u32x2*)(xb + (size_t)m * DM) + lane; u32x2* o1 = (u32x2*)(xb + (size_t)m2 * DM) + lane;
#pragma unroll
        for (int j = 0; j < 4; ++j) { u32x2 w; w.x = cvt_pk_bf16(v0[j].x, v0[j].y); w.y = cvt_pk_bf16(v0[j].z, v0[j].w); o0[64 * j] = w;
                                      u32x2 w2; w2.x = cvt_pk_bf16(v1[j].x, v1[j].y); w2.y = cvt_pk_bf16(v1[j].z, v1[j].w); o1[64 * j] = w2; }
        if (lane < 16) { ssq[(size_t)m * 32 + lane] = (lane == 0) ? s0 : 0.f; ssq[(size_t)m2 * 32 + lane] = (lane == 0) ? s1 : 0.f; }
    }
}

constexpr int HQD = 0, HKI = 8704, HKET = 17408, HVT = 27648, HDEC = 37888, HCS = 38400, HPS = 40448;
__device__ __forceinline__ bf16x8 pack8(const f32x4& a, const f32x4& b) {
    u32x4 w; w.x = cvt_pk_bf16(a[0], a[1]); w.y = cvt_pk_bf16(a[2], a[3]); w.z = cvt_pk_bf16(b[0], b[1]); w.w = cvt_pk_bf16(b[2], b[3]); return __builtin_bit_cast(bf16x8, w);
}
__device__ __forceinline__ bf16x8 ld2x8(const LAS bf16_t* p0, const LAS bf16_t* p1) {
    const u32x2 a = *(const LAS u32x2*)p0, b = *(const LAS u32x2*)p1; u32x4 w; w.x = a.x; w.y = a.y; w.z = b.x; w.w = b.y; return __builtin_bit_cast(bf16x8, w);
}
template <bool OUT>
__device__ __forceinline__ void hgrn_mma(const Params& p, int it, LAS unsigned char* lds) {
    const int tid = otid(), lane = tid & 63, wave = __builtin_amdgcn_readfirstlane(tid >> 6), fr = lane & 15, fq = lane >> 4;
    const int b = it >> 6, h = (it >> 4) & 3, seg = it & 15;
    const int dk = tid & 127, tq = tid >> 7;
    LAS bf16_t* Qd = (LAS bf16_t*)(lds + HQD); LAS bf16_t* Ki = (LAS bf16_t*)(lds + HKI); LAS bf16_t* KeT = (LAS bf16_t*)(lds + HKET); LAS bf16_t* VT = (LAS bf16_t*)(lds + HVT);
    LAS float* dec = (LAS float*)(lds + HDEC); LAS float* cs = (LAS float*)(lds + HCS); LAS float* ps = (LAS float*)(lds + HPS);
    const size_t tok0 = (size_t)b * SEQ + (size_t)seg * HSEG;
    const float* Fp = (const float*)(p.ws + WS_F) + tok0 * 512 + h * 128 + dk;
    const float* Qp = (const float*)(p.ws + WS_QS) + tok0 * 512 + h * 128 + dk;
    const bf16_t* proj = (const bf16_t*)(p.ws + WS_ACT);
    const bf16_t* Vp = proj + tok0 * MIXIN + 1792 + h * 128 + dk;
    bf16_t* cat = (bf16_t*)(p.ws + WS_CAT);
    f32x4* HS4 = (f32x4*)(p.ws + WS_HS); float* HD = (float*)(p.ws + WS_HD);
    f32x4 S[8];
#pragma unroll
    for (int mb = 0; mb < 8; ++mb) S[mb] = (f32x4){0.f, 0.f, 0.f, 0.f};
    if (OUT) {
        f32x4 Pd[8];
#pragma unroll
        for (int mb = 0; mb < 8; ++mb) Pd[mb] = (f32x4){1.f, 1.f, 1.f, 1.f};
#pragma unroll 2
        for (int v = seg - 1; v >= 0; --v) { const int itv = it - seg + v;
#pragma unroll
            for (int mb = 0; mb < 8; ++mb) { const f32x4 x = HS4[(((size_t)itv * 8 + wave) * 8 + mb) * 64 + lane]; const f32x4 d4 = *(const f32x4*)(HD + (size_t)itv * 128 + mb * 16 + fq * 4);
                S[mb] = S[mb] + Pd[mb] * x; Pd[mb] = Pd[mb] * d4; } }
    }
    float dlog = 0.f;
    const int dvrow = wave * 16 + fr;
    const bf16_t* Gp = proj + tok0 * MIXIN + 2304 + h * 128 + wave * 16 + fq * 4;
    float fvA[8], qvA[8], fvB[8], qvB[8]; unsigned short vvA[8], vvB[8]; u32x2 gA0, gA1, gB0, gB1;
#define HG_LOAD(fv, qv, vv, g0, g1, cc) do { const int c_ = (cc) < (HSEG / 32) ? (cc) : (HSEG / 32 - 1); \
        _Pragma("unroll") for (int r = 0; r < 8; ++r) { const size_t t = (size_t)(c_ * 32 + tq * 8 + r); fv[r] = Fp[t * 512]; if (OUT) qv[r] = Qp[t * 512]; vv[r] = Vp[t * MIXIN]; } \
        if (OUT) { g0 = *(const u32x2*)(Gp + (size_t)(c_ * 32 + fr) * MIXIN); g1 = *(const u32x2*)(Gp + (size_t)(c_ * 32 + 16 + fr) * MIXIN); } } while (0)
#define HG_CHUNK(fv, qv, vv, g0, g1, c) do { \
        float cum[8]; float run = 0.f; \
        _Pragma("unroll") for (int r = 0; r < 8; ++r) { run += __logf(fv[r]); cum[r] = run; } \
        if (OUT && (c) > 0) { *(u32x2*)(cat + ptok * DM + 512 + h * 128 + wave * 16 + fq * 4) = pwA; *(u32x2*)(cat + (ptok + 16) * DM + 512 + h * 128 + wave * 16 + fq * 4) = pwB; } \
        cs[tq * 128 + dk] = run; \
        asm volatile("s_waitcnt lgkmcnt(0)" ::: "memory"); __builtin_amdgcn_s_barrier(); asm volatile("" ::: "memory");        \
        float off = 0.f, tot = 0.f; \
        _Pragma("unroll") for (int q = 0; q < 4; ++q) { const float x = cs[q * 128 + dk]; tot += x; if (q < tq) off += x; } \
        float ke[8]; \
        _Pragma("unroll") for (int r = 0; r < 8; ++r) { const float cm = cum[r] + off, k = 1.f - fv[r]; const int t = tq * 8 + r; \
            if (OUT) { Qd[t * 136 + dk] = (bf16_t)(cvt_pk_bf16(qv[r] * __expf(cm), 0.f) & 0xffffu); Ki[t * 136 + dk] = (bf16_t)(cvt_pk_bf16(k * __expf(-cm), 0.f) & 0xffffu); } \
            ke[r] = k * __expf(tot - cm); if ((r & 3) == 3) asm volatile("s_waitcnt lgkmcnt(0)" ::: "memory"); } \
        { u32x4 w; w.x = cvt_pk_bf16(ke[0], ke[1]); w.y = cvt_pk_bf16(ke[2], ke[3]); w.z = cvt_pk_bf16(ke[4], ke[5]); w.w = cvt_pk_bf16(ke[6], ke[7]); *(LAS u32x4*)(KeT + dk * 40 + tq * 8) = w; } \
        { u32x4 w; w.x = (unsigned)vv[0] | ((unsigned)vv[1] << 16); w.y = (unsigned)vv[2] | ((unsigned)vv[3] << 16); w.z = (unsigned)vv[4] | ((unsigned)vv[5] << 16); w.w = (unsigned)vv[6] | ((unsigned)vv[7] << 16); \
          *(LAS u32x4*)(VT + dk * 40 + tq * 8) = w; } \
        if (tq == 0) { dec[dk] = __expf(tot); dlog += tot; } \
        const u32x2 gc0 = g0, gc1 = g1; \
        HG_LOAD(fv, qv, vv, g0, g1, (c) + 2);                                                                                    \
        asm volatile("s_waitcnt lgkmcnt(0)" ::: "memory"); __builtin_amdgcn_s_barrier(); asm volatile("" ::: "memory");        \
        f32x4 o0 = (f32x4){0.f, 0.f, 0.f, 0.f}, o1 = o0; \
        if (OUT) { \
            f32x4 sc00 = o0, sc01 = o0, sc11 = o0; \
            _Pragma("unroll") for (int ks = 0; ks < 4; ++ks) { \
                const bf16x8 a0 = *(const LAS bf16x8*)(Ki + fr * 136 + ks * 32 + fq * 8), a1 = *(const LAS bf16x8*)(Ki + (16 + fr) * 136 + ks * 32 + fq * 8); \
                const bf16x8 b0 = *(const LAS bf16x8*)(Qd + fr * 136 + ks * 32 + fq * 8), b1 = *(const LAS bf16x8*)(Qd + (16 + fr) * 136 + ks * 32 + fq * 8); \
                sc00 = __builtin_amdgcn_mfma_f32_16x16x32_bf16(a0, b0, sc00, 0, 0, 0); \
                sc01 = __builtin_amdgcn_mfma_f32_16x16x32_bf16(a0, b1, sc01, 0, 0, 0); \
                sc11 = __builtin_amdgcn_mfma_f32_16x16x32_bf16(a1, b1, sc11, 0, 0, 0); asm volatile("s_waitcnt lgkmcnt(0)" ::: "memory"); } \
            _Pragma("unroll") for (int j = 0; j < 4; ++j) if (fq * 4 + j > fr) { sc00[j] = 0.f; sc11[j] = 0.f; } \
            const bf16x8 Pb0 = pack8(sc00, (f32x4){0.f, 0.f, 0.f, 0.f}), Pb1 = pack8(sc01, sc11); \
            const bf16x8 Va = ld2x8(VT + dvrow * 40 + fq * 4, VT + dvrow * 40 + 16 + fq * 4); \
            f32x4 o0b = o0, o1b = o0; \
            o0 = __builtin_amdgcn_mfma_f32_16x16x32_bf16(Va, Pb0, o0, 0, 0, 0); \
            o1 = __builtin_amdgcn_mfma_f32_16x16x32_bf16(Va, Pb1, o1, 0, 0, 0); \
            _Pragma("unroll") for (int ks = 0; ks < 4; ++ks) { \
                const bf16x8 Sa = pack8(S[2 * ks], S[2 * ks + 1]); \
                const bf16x8 q0 = ld2x8(Qd + fr * 136 + (2 * ks) * 16 + fq * 4, Qd + fr * 136 + (2 * ks + 1) * 16 + fq * 4); \
                const bf16x8 q1 = ld2x8(Qd + (16 + fr) * 136 + (2 * ks) * 16 + fq * 4, Qd + (16 + fr) * 136 + (2 * ks + 1) * 16 + fq * 4); \
                if (ks & 1) { o0b = __builtin_amdgcn_mfma_f32_16x16x32_bf16(Sa, q0, o0b, 0, 0, 0); o1b = __builtin_amdgcn_mfma_f32_16x16x32_bf16(Sa, q1, o1b, 0, 0, 0); } \
                else { o0 = __builtin_amdgcn_mfma_f32_16x16x32_bf16(Sa, q0, o0, 0, 0, 0); o1 = __builtin_amdgcn_mfma_f32_16x16x32_bf16(Sa, q1, o1, 0, 0, 0); } asm volatile("s_waitcnt lgkmcnt(0)" ::: "memory"); } \
            o0 = o0 + o0b; o1 = o1 + o1b; \
        } \
        {     \
            const bf16x8 vb = *(const LAS bf16x8*)(VT + dvrow * 40 + fq * 8); \
            _Pragma("unroll") for (int mb = 0; mb < 8; ++mb) { const f32x4 d4 = *(const LAS f32x4*)(dec + mb * 16 + fq * 4); const bf16x8 ka = *(const LAS bf16x8*)(KeT + (mb * 16 + fr) * 40 + fq * 8); \
                S[mb] = __builtin_amdgcn_mfma_f32_16x16x32_bf16(ka, vb, S[mb] * d4, 0, 0, 0); if (mb & 1) asm volatile("s_waitcnt lgkmcnt(0)" ::: "memory"); } \
        } \
        if (OUT) { \
            const size_t tokA = tok0 + (size_t)(c) * 32 + fr, tokB = tokA + 16; \
            float pp0 = (o0[0] * o0[0] + o0[1] * o0[1]) + (o0[2] * o0[2] + o0[3] * o0[3]), pp1 = (o1[0] * o1[0] + o1[1] * o1[1]) + (o1[2] * o1[2] + o1[3] * o1[3]); \
            pp0 += __shfl_xor(pp0, 16); pp0 += __shfl_xor(pp0, 32); pp1 += __shfl_xor(pp1, 16); pp1 += __shfl_xor(pp1, 32); \
            if (fq == 0) { ps[wave * 32 + fr] = pp0; ps[wave * 32 + 16 + fr] = pp1; } \
            asm volatile("s_waitcnt lgkmcnt(0)" ::: "memory"); __builtin_amdgcn_s_barrier(); asm volatile("" ::: "memory");    \
            float s0 = 0.f, s1 = 0.f; \
            _Pragma("unroll") for (int w = 0; w < 8; ++w) { s0 += ps[w * 32 + fr]; s1 += ps[w * 32 + 16 + fr]; } \
            const float rn0 = rsqrtf(s0 * (1.f / 128.f) + EPS), rn1 = rsqrtf(s1 * (1.f / 128.f) + EPS); \
            u32x2 wA, wB; \
            wA.x = cvt_pk_bf16(o0[0] * rn0 * siluf_(bflo(gc0.x)), o0[1] * rn0 * siluf_(bfhi(gc0.x))); wA.y = cvt_pk_bf16(o0[2] * rn0 * siluf_(bflo(gc0.y)), o0[3] * rn0 * siluf_(bfhi(gc0.y))); \
            wB.x = cvt_pk_bf16(o1[0] * rn1 * siluf_(bflo(gc1.x)), o1[1] * rn1 * siluf_(bfhi(gc1.x))); wB.y = cvt_pk_bf16(o1[2] * rn1 * siluf_(bflo(gc1.y)), o1[3] * rn1 * siluf_(bfhi(gc1.y))); \
            pwA = wA; pwB = wB; ptok = tokA; (void)tokB;        \
        } } while (0)
    u32x2 pwA = {0u, 0u}, pwB = {0u, 0u}; size_t ptok = 0;
    HG_LOAD(fvA, qvA, vvA, gA0, gA1, 0);
    HG_LOAD(fvB, qvB, vvB, gB0, gB1, 1);
#pragma unroll 1
    for (int c = 0; c < HSEG / 32; c += 2) {
        HG_CHUNK(fvA, qvA, vvA, gA0, gA1, c);
        HG_CHUNK(fvB, qvB, vvB, gB0, gB1, c + 1);
    }
    if (OUT) { *(u32x2*)(cat + ptok * DM + 512 + h * 128 + wave * 16 + fq * 4) = pwA; *(u32x2*)(cat + (ptok + 16) * DM + 512 + h * 128 + wave * 16 + fq * 4) = pwB; }
#undef HG_LOAD
#undef HG_CHUNK
    if (!OUT) {
#pragma unroll
        for (int mb = 0; mb < 8; ++mb) HS4[(((size_t)it * 8 + wave) * 8 + mb) * 64 + lane] = S[mb];
        if (tq == 0) HD[(size_t)it * 128 + dk] = __expf(dlog);
    }
    __syncthreads();
}


constexpr int AKS = 72, AVS = 268;
constexpr int AK_OFF = 0, AV_OFF = 256 * AKS * 2;
__device__ __forceinline__ void attn_mma(const Params& p, int e, LAS unsigned char* lds, int G) {
    const int tid = otid(), lane = tid & 63, wave = __builtin_amdgcn_readfirstlane(tid >> 6), fr = lane & 15, fq = lane >> 4;
    LAS bf16_t* Ks = (LAS bf16_t*)(lds + AK_OFF); LAS bf16_t* VTs = (LAS bf16_t*)(lds + AV_OFF);
    const bf16_t* P = (const bf16_t*)(p.ws + WS_ACT); bf16_t* cat = (bf16_t*)(p.ws + WS_CAT);
    const int g = wave >> 1, half = wave & 1;
    for (int item = obid(); item < 512; item += G) {
        const int kvh = item & 1, nbi = (item >> 1) & 63, b = item >> 7, hq = kvh * 4 + g;
        const size_t tokblk = (size_t)b * SEQ + (size_t)nbi * 128;
        const bf16_t* qsrc = P + (tokblk + half * 64 + fr) * MIXIN + hq * 64 + fq * 8;
        bf16x8 qn0 = *(const bf16x8*)qsrc, qn1 = *(const bf16x8*)(qsrc + 32);
#pragma unroll
        for (int i = 0; i < 4; ++i) {
            const int id = tid + 512 * i, row = id >> 3, ch = id & 7;
            int tk = nbi * 128 - 128 + row; if (tk < 0) tk = 0;
            const bf16_t* src = P + ((size_t)b * SEQ + tk) * MIXIN + 512 + kvh * 64 + ch * 8;
            const u32x4 kq = *(const u32x4*)src, vq = *(const u32x4*)(src + 128);
            *(LAS u32x4*)(Ks + row * AKS + ch * 8) = kq;
            LAS bf16_t* vd = VTs + (ch * 8) * AVS + row;
            vd[0 * AVS] = (bf16_t)(vq.x & 0xffffu); vd[1 * AVS] = (bf16_t)(vq.x >> 16); vd[2 * AVS] = (bf16_t)(vq.y & 0xffffu); vd[3 * AVS] = (bf16_t)(vq.y >> 16);
            vd[4 * AVS] = (bf16_t)(vq.z & 0xffffu); vd[5 * AVS] = (bf16_t)(vq.z >> 16); vd[6 * AVS] = (bf16_t)(vq.w & 0xffffu); vd[7 * AVS] = (bf16_t)(vq.w >> 16);
            asm volatile("s_waitcnt lgkmcnt(0)" ::: "memory");
        }
        asm volatile("s_waitcnt lgkmcnt(0)" ::: "memory"); __builtin_amdgcn_s_barrier(); asm volatile("" ::: "memory");
        const float slope = exp2f(-(float)(hq + 1)), sink = p.attn_sinks[e * 8 + hq];
#pragma unroll 1
        for (int rb4 = 0; rb4 < 4; ++rb4) {
            const int rbase = half * 64 + rb4 * 16, rb = rbase >> 4, irow = rbase + fr;
            const bf16x8 q0 = qn0, q1 = qn1;
            { const int rn = rb4 < 3 ? rb4 + 1 : 3; qn0 = *(const bf16x8*)(qsrc + (size_t)rn * 16 * MIXIN); qn1 = *(const bf16x8*)(qsrc + (size_t)rn * 16 * MIXIN + 32); }
            f32x4 sc[10];
#pragma unroll
            for (int kbi = 0; kbi < 10; ++kbi) {
                const int kb = (rb + kbi) < 15 ? (rb + kbi) : 15;
                const bf16x8 a0 = *(const LAS bf16x8*)(Ks + (kb * 16 + fr) * AKS + fq * 8), a1 = *(const LAS bf16x8*)(Ks + (kb * 16 + fr) * AKS + 32 + fq * 8);
                f32x4 r = __builtin_amdgcn_mfma_f32_16x16x32_bf16(a0, q0, (f32x4){0.f, 0.f, 0.f, 0.f}, 0, 0, 0);
                sc[kbi] = __builtin_amdgcn_mfma_f32_16x16x32_bf16(a1, q1, r, 0, 0, 0);
                if (kbi & 1) asm volatile("s_waitcnt lgkmcnt(0)" ::: "memory");
            }
            float mx = sink;
#pragma unroll
            for (int kbi = 0; kbi < 10; ++kbi)
#pragma unroll
                for (int jj = 0; jj < 4; ++jj) {
                    const int j = (rb + kbi) * 16 + fq * 4 + jj, dist = irow + 128 - j;
                    const bool valid = (dist >= 0) && (dist < 128) && (nbi > 0 || j >= 128);
                    const float sv = valid ? (sc[kbi][jj] * 0.125f - slope * (float)dist) : -INFINITY;
                    sc[kbi][jj] = sv; mx = fmaxf(mx, sv);
                }
            mx = fmaxf(mx, __shfl_xor(mx, 16)); mx = fmaxf(mx, __shfl_xor(mx, 32));
            float l = 0.f;
#pragma unroll
            for (int kbi = 0; kbi < 10; ++kbi)
#pragma unroll
                for (int jj = 0; jj < 4; ++jj) { const float pv = __expf(sc[kbi][jj] - mx); sc[kbi][jj] = pv; l += pv; }
            l += __shfl_xor(l, 16); l += __shfl_xor(l, 32); l += __expf(sink - mx);
            f32x4 O[4];
#pragma unroll
            for (int db = 0; db < 4; ++db) O[db] = (f32x4){0.f, 0.f, 0.f, 0.f};
#pragma unroll
            for (int pi = 0; pi < 5; ++pi) {
                const int kb0 = (rb + 2 * pi) < 15 ? (rb + 2 * pi) : 15, kb1 = (rb + 2 * pi + 1) < 15 ? (rb + 2 * pi + 1) : 15;
                const bf16x8 Pb = pack8(sc[2 * pi], sc[2 * pi + 1]);
#pragma unroll
                for (int db = 0; db < 4; ++db) {
                    const bf16x8 Va = ld2x8(VTs + (db * 16 + fr) * AVS + kb0 * 16 + fq * 4, VTs + (db * 16 + fr) * AVS + kb1 * 16 + fq * 4);
                    O[db] = __builtin_amdgcn_mfma_f32_16x16x32_bf16(Va, Pb, O[db], 0, 0, 0);
                }
                asm volatile("s_waitcnt lgkmcnt(0)" ::: "memory");
            }
            const float inv = fast_rcp(l);
            bf16_t* op = cat + (tokblk + irow) * DM + hq * 64 + fq * 4;
#pragma unroll
            for (int db = 0; db < 4; ++db) { u32x2 w; w.x = cvt_pk_bf16(O[db][0] * inv, O[db][1] * inv); w.y = cvt_pk_bf16(O[db][2] * inv, O[db][3] * inv); *(u32x2*)(op + db * 16) = w; }
        }
        asm volatile("s_waitcnt lgkmcnt(0)" ::: "memory"); __builtin_amdgcn_s_barrier(); asm volatile("" ::: "memory");
    }
}

constexpr int S5_SEG = SEQ / NWAVES;
__device__ __forceinline__ void s5_phase(const Params& p, int layer, int oi, LAS unsigned char* lds, int G) {
    const int tid = otid(), lane = tid & 63, wave = __builtin_amdgcn_readfirstlane(tid >> 6);
    LAS unsigned char* wl = lds + wave * 16384;
    LAS bf16_t* U_bf = (LAS bf16_t*)wl;
    LAS float* U_f = (LAS float*)(wl + 1024);
    LAS float* BU = (LAS float*)(wl + 2048);
    LAS bf16_t* XH = (LAS bf16_t*)(wl + 2048 + 8448);
    LAS float* XCH = (LAS float*)(lds + TBL_OFF + 2048);
    const bf16_t* X = (const bf16_t*)(p.ws + WS_XB); const float* ssq = (const float*)(p.ws + WS_SSQ); bf16_t* yb = (bf16_t*)(p.ws + WS_CAT);
    const int fr = lane & 15, fq = lane >> 4;
    const int bid_ = obid(), vb_ = (G % 8 == 0) ? (bid_ % 8) * (G / 8) + bid_ / 8 : bid_;
    for (int item = vb_; item < BATCH * 64; item += G) {
        const int b = item >> 6, g = item & 63;
        const size_t gp = ((size_t)oi * 64 + g) * 64 + lane;
        const float lr = p.s5_a_re[gp], li = p.s5_a_im[gp];
        const float step = __expf(p.s5_log_step[oi * 64 + g]);
        const float mag = expf(step * lr);
        float sn, cs; sincosf(step * li, &sn, &cs);
        const float abr = mag * cs, abi = mag * sn;
        const float den = lr * lr + li * li;
        const float cfr = ((abr - 1.f) * lr + abi * li) / den, cfi = (abi * lr - (abr - 1.f) * li) / den;
        {
            LAS bf16_t* BBm = (LAS bf16_t*)BU;
            const f32x4* brp = (const f32x4*)(p.s5_b_re + gp * 16); const f32x4* bip = (const f32x4*)(p.s5_b_im + gp * 16);
            unsigned wr_[8], wi_[8];
#pragma unroll
            for (int c4 = 0; c4 < 4; ++c4) { const f32x4 br = brp[c4], bi = bip[c4];
                float r_[4], i_[4];
#pragma unroll
                for (int j = 0; j < 4; ++j) { r_[j] = cfr * br[j] - cfi * bi[j]; i_[j] = cfr * bi[j] + cfi * br[j]; }
                wr_[c4 * 2] = cvt_pk_bf16(r_[0], r_[1]); wr_[c4 * 2 + 1] = cvt_pk_bf16(r_[2], r_[3]); wi_[c4 * 2] = cvt_pk_bf16(i_[0], i_[1]); wi_[c4 * 2 + 1] = cvt_pk_bf16(i_[2], i_[3]); }
            LAS u32x4* rr = (LAS u32x4*)(BBm + lane * 32); LAS u32x4* ri = (LAS u32x4*)(BBm + (64 + lane) * 32);
            rr[0] = (u32x4){wr_[0], wr_[1], wr_[2], wr_[3]}; rr[1] = (u32x4){wr_[4], wr_[5], wr_[6], wr_[7]}; rr[2] = (u32x4){0u, 0u, 0u, 0u}; rr[3] = (u32x4){0u, 0u, 0u, 0u}; asm volatile("s_waitcnt lgkmcnt(0)" ::: "memory");
            ri[0] = (u32x4){wi_[0], wi_[1], wi_[2], wi_[3]}; ri[1] = (u32x4){wi_[4], wi_[5], wi_[6], wi_[7]}; ri[2] = (u32x4){0u, 0u, 0u, 0u}; ri[3] = (u32x4){0u, 0u, 0u, 0u};
            asm volatile("" ::: "memory");
        }
        bf16x8 Bop[8], Cop[4];
#pragma unroll
        for (int nb = 0; nb < 8; ++nb) Bop[nb] = *(const LAS bf16x8*)((LAS bf16_t*)BU + (nb * 16 + fr) * 32 + fq * 8);
#pragma unroll
        for (int ks = 0; ks < 4; ++ks) {
            const float* src = ((ks < 2) ? p.s5_c_re : p.s5_c_im) + (((size_t)oi * 64 + g) * 16 + fr) * 64 + (ks & 1) * 32 + fq * 8;
            const f32x4 a = *(const f32x4*)src, c = *(const f32x4*)(src + 4); const float sg = (ks < 2) ? 1.f : -1.f;
            u32x4 w; w.x = cvt_pk_bf16(sg * a[0], sg * a[1]); w.y = cvt_pk_bf16(sg * a[2], sg * a[3]); w.z = cvt_pk_bf16(sg * c[0], sg * c[1]); w.w = cvt_pk_bf16(sg * c[2], sg * c[3]);
            Cop[ks] = __builtin_bit_cast(bf16x8, w);
        }
        const float dsk = p.s5_d[oi * DM + g * 16 + fr];
        const int ut = lane >> 2, ucq = lane & 3;
        const f32x4 gn4 = *(const f32x4*)(p.norm_g + (size_t)(layer * 3 + 1) * DM + g * 16 + ucq * 4);
        asm volatile("s_waitcnt lgkmcnt(0)" ::: "memory");
        { LAS u32x4* z = (LAS u32x4*)U_bf; z[lane] = (u32x4){0u, 0u, 0u, 0u}; } asm volatile("" ::: "memory");
        const size_t tokbase = (size_t)b * SEQ + (size_t)wave * S5_SEG;
        float xr = 0.f, xi = 0.f;
        bf16_t yprev[4] = {0, 0, 0, 0};
#pragma unroll 1
        for (int pass = 0; pass < 2; ++pass) {
            u32x2 xn = *(const u32x2*)(X + (tokbase + ut) * DM + g * 16 + ucq * 4);
            f32x4 sq = *(const f32x4*)(ssq + (tokbase + ut) * 32 + ucq * 4);
#pragma unroll 1
            for (int t0 = 0; t0 < S5_SEG; t0 += 16) {
                const f32x4 xc = (f32x4){bflo(xn.x), bfhi(xn.x), bflo(xn.y), bfhi(xn.y)}, sc = sq;
                { const int tn = (t0 + 16 < S5_SEG) ? (t0 + 16) : t0;
                  xn = *(const u32x2*)(X + (tokbase + tn + ut) * DM + g * 16 + ucq * 4); sq = *(const f32x4*)(ssq + (tokbase + tn + ut) * 32 + ucq * 4); }
                if (pass && t0 > 0) {
#pragma unroll
                    for (int j = 0; j < 4; ++j) yb[(tokbase + t0 - 16 + fq * 4 + j) * DM + g * 16 + fr] = yprev[j];
                }
                float s = (sc.x + sc.y) + (sc.z + sc.w);
                s += __int_as_float(__builtin_amdgcn_mov_dpp(__float_as_int(s), 0xB1, 0xF, 0xF, true));
                s += __int_as_float(__builtin_amdgcn_mov_dpp(__float_as_int(s), 0x4E, 0xF, 0xF, true));
                const float rs = rsqrtf(s * (1.f / DM) + EPS);
                const f32x4 u4 = xc * rs * gn4;
                *(LAS f32x4*)(U_f + ut * 16 + ucq * 4) = u4;
                { u32x2 w; w.x = cvt_pk_bf16(u4[0], u4[1]); w.y = cvt_pk_bf16(u4[2], u4[3]); *(LAS u32x2*)(U_bf + ut * 32 + ucq * 4) = w; } asm volatile("" ::: "memory");
                const bf16x8 ua = *(const LAS bf16x8*)(U_bf + fr * 32 + fq * 8);
#pragma unroll
                for (int nb = 0; nb < 8; ++nb) {
                    f32x4 r = __builtin_amdgcn_mfma_f32_16x16x32_bf16(ua, Bop[nb], (f32x4){0.f, 0.f, 0.f, 0.f}, 0, 0, 0);
#pragma unroll
                    for (int j = 0; j < 4; ++j) BU[(fq * 4 + j) * 132 + nb * 16 + fr] = r[j];
                } asm volatile("" ::: "memory");
                float br_[16], bi_[16];
#pragma unroll
                for (int tt = 0; tt < 16; ++tt) { br_[tt] = BU[tt * 132 + lane]; bi_[tt] = BU[tt * 132 + 64 + lane]; if ((tt & 7) == 7) asm volatile("s_waitcnt lgkmcnt(0)" ::: "memory"); }
#pragma unroll
                for (int tt = 0; tt < 16; ++tt) {
                    const float bur = br_[tt], bui = bi_[tt];
                    const float nxr = abr * xr - abi * xi + bur, nxi = abr * xi + abi * xr + bui;
                    xr = nxr; xi = nxi;
                    if (pass) { XH[tt * 136 + lane] = (bf16_t)(cvt_pk_bf16(xr, 0.f) & 0xffffu); XH[tt * 136 + 64 + lane] = (bf16_t)(cvt_pk_bf16(xi, 0.f) & 0xffffu); }
                } asm volatile("" ::: "memory");
                if (pass) {
                    f32x4 y = (f32x4){0.f, 0.f, 0.f, 0.f};
#pragma unroll
                    for (int ks = 0; ks < 4; ++ks) { const bf16x8 xa = *(const LAS bf16x8*)(XH + fr * 136 + ks * 32 + fq * 8); y = __builtin_amdgcn_mfma_f32_16x16x32_bf16(xa, Cop[ks], y, 0, 0, 0); }
#pragma unroll
                    for (int j = 0; j < 4; ++j) { const int t = fq * 4 + j; const float v = gelu_tanh(y[j] + dsk * U_f[t * 16 + fr]);
                        yprev[j] = (bf16_t)(cvt_pk_bf16(v, 0.f) & 0xffffu); }
                } asm volatile("" ::: "memory");
            }
            if (pass) {
#pragma unroll
                for (int j = 0; j < 4; ++j) yb[(tokbase + S5_SEG - 16 + fq * 4 + j) * DM + g * 16 + fr] = yprev[j];
            }
            if (pass == 0) {
                XCH[(wave * 64 + lane) * 2] = xr; XCH[(wave * 64 + lane) * 2 + 1] = xi;
                float pr = abr, pi = abi;
#pragma unroll
                for (int q = 0; q < 10; ++q) { const float nr = pr * pr - pi * pi, ni = 2.f * pr * pi; pr = nr; pi = ni; }
                __syncthreads();
                float sr = 0.f, si = 0.f;
                for (int v = 0; v < wave; ++v) { const float er = XCH[(v * 64 + lane) * 2], ei = XCH[(v * 64 + lane) * 2 + 1];
                    const float nr = pr * sr - pi * si + er, ni = pr * si + pi * sr + ei; sr = nr; si = ni; }
                xr = sr; xi = si;
            }
        }
        __syncthreads();
    }
}

__device__ __forceinline__ void final_norm(const Params& p, int G) {
    const int tid = otid(), lane = tid & 63, wave = tid >> 6;
    const int gw = obid() * NWAVES + wave, NGW = G * NWAVES;
    const bf16_t* xb = (const bf16_t*)(p.ws + WS_XB);
    f32x4 gv[4];
#pragma unroll
    for (int j = 0; j < 4; ++j) gv[j] = ((const f32x4*)p.final_g)[lane + 64 * j];
    for (int m = gw; m < M; m += NGW) {
        const u32x2* xr = (const u32x2*)(xb + (size_t)m * DM) + lane;
        f32x4* orow = (f32x4*)(p.out + (size_t)m * DM) + lane;
        f32x4 v[4]; float s = 0.f;
#pragma unroll
        for (int j = 0; j < 4; ++j) { const u32x2 w = xr[64 * j]; v[j] = (f32x4){bflo(w.x), bfhi(w.x), bflo(w.y), bfhi(w.y)}; s += (v[j].x * v[j].x + v[j].y * v[j].y) + (v[j].z * v[j].z + v[j].w * v[j].w); }
        const float rs = rsqrtf(wave_sum(s) * (1.f / DM) + EPS);
#pragma unroll
        for (int j = 0; j < 4; ++j) orow[64 * j] = v[j] * rs * gv[j];
    }
}

#define XB_TMO      128
#define XB_XCNT(j)  (256  + 64 * (j))
#define XB_XSUB(j)  (1280 + 64 * (j))
#define XB_XGEN(j)  (2304 + 64 * (j))
#define XB_TOP      3328
#define XB_TOPGEN   3392
#define XCD_BAR_WORDS 3456
#define XB_SPIN_CAP (1u << 18)
__device__ __forceinline__ unsigned xb_ld(unsigned* p)              { return __hip_atomic_load(p, __ATOMIC_RELAXED, __HIP_MEMORY_SCOPE_AGENT); }
__device__ __forceinline__ unsigned xb_add(unsigned* p, unsigned v) { return __hip_atomic_fetch_add(p, v, __ATOMIC_RELAXED, __HIP_MEMORY_SCOPE_AGENT); }
__device__ __forceinline__ unsigned xb_xcc_id() { return (unsigned)__builtin_amdgcn_s_getreg((3 << 11) | 20) & 0xFu; }
#define XB_SPIN(cond, bar) do { unsigned _sp = 0; while (cond) { __builtin_amdgcn_s_sleep(1); \
    if ((++_sp & 255u) == 0u) { if (xb_ld(&(bar)[XB_TMO])) break; if (_sp > XB_SPIN_CAP) { atomicAdd(&(bar)[XB_TMO], 1u); break; } } } } while (0)
struct XcdBarrier { unsigned* bar; unsigned x; volatile LAS unsigned* st; };
__device__ __forceinline__ XcdBarrier xcd_barrier_post(unsigned* bar, volatile LAS unsigned* st) {
    XcdBarrier b; b.bar = bar; b.x = xb_xcc_id(); b.st = st;
    if (threadIdx.x == 0) (void)xb_add(&bar[XB_XCNT(b.x)], 1u);
    return b;
}
__device__ __forceinline__ void xcd_barrier_complete(unsigned* bar, unsigned x, unsigned& nloc, unsigned& nx) {
    const unsigned G = gridDim.x * gridDim.y * gridDim.z;
    unsigned sum, cnt, mine, sp = 0u;
    for (;;) {
        sum = 0u; cnt = 0u; mine = 0u;
#pragma unroll
        for (unsigned j = 0; j < 16; ++j) { const unsigned c = xb_ld(&bar[XB_XCNT(j)]); sum += c; cnt += (c > 0u) ? 1u : 0u; mine = (j == x) ? c : mine; }
        if (sum == G) break;
        __builtin_amdgcn_s_sleep(1);
        if ((++sp & 255u) == 0u) { if (xb_ld(&bar[XB_TMO])) break; if (sp > XB_SPIN_CAP) { atomicAdd(&bar[XB_TMO], 1u); break; } }
    }
    nloc = mine > 0u ? mine : 1u; nx = cnt > 0u ? cnt : 1u;
}
__device__ __forceinline__ void xcd_barrier(const XcdBarrier& b) {
    asm volatile("s_waitcnt vmcnt(0)" ::: "memory");
    __syncthreads();
    if (threadIdx.x == 0) {
        unsigned* bar = b.bar;
        __builtin_amdgcn_s_waitcnt(0);
        unsigned nloc = b.st[0], nx = b.st[1];
        if (nloc == 0u) { xcd_barrier_complete(bar, b.x, nloc, nx); b.st[0] = nloc; b.st[1] = nx; }
        const unsigned old = xb_add(&bar[XB_XSUB(b.x)], 1u);
        const unsigned gen = old / nloc;
        if (old + 1u == (gen + 1u) * nloc) {
            __builtin_amdgcn_fence(__ATOMIC_RELEASE, "agent");
            asm volatile("s_waitcnt vmcnt(0)" ::: "memory");
            const unsigned og = xb_add(&bar[XB_TOP], 1u);
            const unsigned tg = og / nx;
            if (og + 1u == (tg + 1u) * nx) xb_add(&bar[XB_TOPGEN], 1u);
            else XB_SPIN(xb_ld(&bar[XB_TOPGEN]) == tg, bar);
            __builtin_amdgcn_fence(__ATOMIC_ACQUIRE, "agent");
            xb_add(&bar[XB_XGEN(b.x)], 1u);
            asm volatile("s_waitcnt vmcnt(0)" ::: "memory");
        } else {
            XB_SPIN(xb_ld(&bar[XB_XGEN(b.x)]) == gen, bar);
            __builtin_amdgcn_fence(__ATOMIC_ACQUIRE, "agent");
            asm volatile("s_waitcnt vmcnt(0)" ::: "memory");
        }
    }
    __syncthreads();
}

__global__ void __launch_bounds__(NWAVES * 64, 2) hybrid_fwd(Params p) {
    extern __shared__ __attribute__((aligned(16))) unsigned char lds_raw[];
    LAS unsigned char* lds = (LAS unsigned char*)lds_raw;
    cg::grid_group grid = cg::this_grid();
    const int G = gridDim.x;
    unsigned char* ws = p.ws;
    bf16_t* xb = (bf16_t*)(ws + WS_XB); bf16_t* act = (bf16_t*)(ws + WS_ACT); bf16_t* cat = (bf16_t*)(ws + WS_CAT);
    float* ssq = (float*)(ws + WS_SSQ);
    LAS float* tbl = (LAS float*)(lds + TBL_OFF);

    volatile LAS unsigned* misc = (volatile LAS unsigned*)(lds + MISC_OFF);
    if (threadIdx.x < 2) misc[threadIdx.x] = 0u;
    __syncthreads();
    const XcdBarrier xbar = xcd_barrier_post((unsigned*)(ws + WS_CTL), misc);
    prologue_phase(p, lds, G);
    grid.sync();

    int np = 16;
    const float* base = p.x;
#pragma unroll 1
    for (int layer = 0; layer < DEPTH; ++layer) {
#pragma unroll 1
        for (int j = 0; j < 2; ++j) {
            const int mi = layer * 2 + j;
            {
                pg8::Gemm g{xb, (const bf16_t*)(ws + WS_WFFN_IN + mi * SZ_WFFN_IN), M, 2 * DFF, DM};
                pg8::StaticOrder S; S.init(M, 2 * DFF, G, obid());
                EpiSwiglu E{act, RsTable{ssq, np, tbl}};
                pg8::gemm_phase<EpiSwiglu>(lds, g, S, E);
            }
            xcd_barrier(xbar);
            {
                pg8::Gemm g{act, (const bf16_t*)(ws + WS_WFFN_OUT + mi * SZ_WFFN_OUT), M, DM, DFF};
                pg8::StaticOrder S; S.init(M, DM, G, obid());
                EpiResid E{base, xb, ssq, 0.5f};
                pg8::gemm_phase<EpiResid>(lds, g, S, E);
            }
            base = nullptr; np = 16;
            xcd_barrier(xbar);
            if (j == 0) {
                if ((layer & 1) == 0) {
                    const int e = layer >> 1;
                    {
                        pg8::Gemm g{xb, (const bf16_t*)(ws + WS_WMIX_IN + e * SZ_WMIX_IN), M, MIXIN, DM};
                        pg8::StaticOrder S; S.init(M, MIXIN, G, obid());
                        EpiMixIn E{act, (float*)(ws + WS_F), (float*)(ws + WS_QS), p.hgrn_lb, e, RsTable{ssq, np, tbl}};
                        pg8::gemm_phase<EpiMixIn>(lds, g, S, E);
                    }
                    xcd_barrier(xbar);
                    for (int it = obid(); it < 256; it += G) hgrn_mma<false>(p, it, lds);
                    attn_mma(p, e, lds, G);
                    xcd_barrier(xbar);
                    for (int it = obid(); it < 256; it += G) hgrn_mma<true>(p, it, lds);
                    xcd_barrier(xbar);
                    {
                        pg8::Gemm g{cat, (const bf16_t*)(ws + WS_WMIX_OUT + e * SZ_WMIX_OUT), M, DM, DM};
                        pg8::StaticOrder S; S.init(M, DM, G, obid());
                        EpiResid E{base, xb, ssq, 1.0f};
                        pg8::gemm_phase<EpiResid>(lds, g, S, E);
                    }
                    np = 16;
                    xcd_barrier(xbar);
                } else {
                    const int oi = layer >> 1;
                    s5_phase(p, layer, oi, lds, G);
                    xcd_barrier(xbar);
                    {
                        pg8::Gemm g{cat, (const bf16_t*)(ws + WS_WGLU + oi * SZ_WGLU), M, 2 * DM, DM};
                        pg8::StaticOrder S; S.init(M, 2 * DM, G, obid());
                        EpiGlu E{xb, ssq};
                        pg8::gemm_phase<EpiGlu>(lds, g, S, E);
                    }
                    np = 32;
                    xcd_barrier(xbar);
                }
            }
        }
    }
    final_norm(p, G);
}

extern "C" void kernel_launch(void* const* d_in, const int* in_sizes, int n_in, void* d_out, int out_size, void* d_ws, size_t ws_size, hipStream_t stream) {
    static int grid = 0;
    if (grid == 0) {
        if (n_in != 18 || in_sizes[0] != M * DM || out_size != M * DM || ws_size < WS_END) {
            fprintf(stderr, "kernel_launch: unexpected shapes: n_in %d in0 %d out %d ws %zu (need %zu)\n", n_in, n_in > 0 ? in_sizes[0] : -1, out_size, ws_size, (size_t)WS_END); grid = -1; return; }
        int dev = 0, cus = 0, per_cu = 0;
        hipGetDevice(&dev);
        hipDeviceGetAttribute(&cus, hipDeviceAttributeMultiprocessorCount, dev);
        if (hipFuncSetAttribute((const void*)hybrid_fwd, hipFuncAttributeMaxDynamicSharedMemorySize, LDS_BYTES) != hipSuccess) { fprintf(stderr, "kernel_launch: hipFuncSetAttribute failed\n"); grid = -1; return; }
        if (hipOccupancyMaxActiveBlocksPerMultiprocessor(&per_cu, (const void*)hybrid_fwd, NWAVES * 64, LDS_BYTES) != hipSuccess || per_cu < 1) { fprintf(stderr, "kernel_launch: occupancy query gave %d\n", per_cu); per_cu = 1; }
        (void)hipGetLastError();
        grid = cus * per_cu;
    }
    if (grid < 0) return;
    if (hipMemsetAsync((char*)d_ws + WS_CTL, 0, CTL_BYTES, stream) != hipSuccess) { fprintf(stderr, "kernel_launch: memset of barrier words failed\n"); return; }
    Params p{};
    const float** pp = (const float**)&p;
    for (int i = 0; i < 18; ++i) pp[i] = (const float*)d_in[i];
    p.out = (float*)d_out; p.ws = (unsigned char*)d_ws;
    void* args[] = {&p};
    hipError_t e = hipLaunchCooperativeKernel((const void*)hybrid_fwd, dim3(grid), dim3(NWAVES * 64), args, LDS_BYTES, stream);
    if (e != hipSuccess) fprintf(stderr, "cooperative launch failed: %s (grid %d)\n", hipGetErrorString(e), grid);
}
```

```cpp
#include <hip/hip_runtime.h>
#include <hip/hip_cooperative_groups.h>
#include <cstdio>
#include <cstdint>
namespace cg = cooperative_groups;

#define LAS __attribute__((address_space(3)))
typedef unsigned short bf16_t;
typedef short bf16x8 __attribute__((ext_vector_type(8)));
typedef float f32x4 __attribute__((ext_vector_type(4)));
typedef float f32x2 __attribute__((ext_vector_type(2)));
typedef unsigned u32x4 __attribute__((ext_vector_type(4)));
typedef unsigned u32x2 __attribute__((ext_vector_type(2)));

constexpr int BATCH = 4, SEQ = 8192, DM = 1024, DEPTH = 4, DFF = 2816;
constexpr int M = BATCH * SEQ;
constexpr int MIXIN = 2816;
constexpr float EPS = 1e-6f;
constexpr int NWAVES = 8;

constexpr size_t SZ_WFFN_IN = (size_t)2 * DFF * DM * 2;
constexpr size_t SZ_WFFN_OUT = (size_t)DM * DFF * 2;
constexpr size_t SZ_WMIX_IN = (size_t)MIXIN * DM * 2;
constexpr size_t SZ_WMIX_OUT = (size_t)DM * DM * 2;
constexpr size_t SZ_WGLU = (size_t)2 * DM * DM * 2;
constexpr size_t WS_WFFN_IN = 0;
constexpr size_t WS_WFFN_OUT = WS_WFFN_IN + 8 * SZ_WFFN_IN;
constexpr size_t WS_WMIX_IN = WS_WFFN_OUT + 8 * SZ_WFFN_OUT;
constexpr size_t WS_WMIX_OUT = WS_WMIX_IN + 2 * SZ_WMIX_IN;
constexpr size_t WS_WGLU = WS_WMIX_OUT + 2 * SZ_WMIX_OUT;
constexpr size_t WS_XB = WS_WGLU + 2 * SZ_WGLU;
constexpr size_t WS_ACT = WS_XB + (size_t)M * DM * 2;
constexpr size_t WS_CAT = WS_ACT + (size_t)M * DFF * 2;
constexpr size_t WS_SSQ = WS_CAT + (size_t)M * DM * 2;
constexpr size_t WS_F = WS_SSQ + (size_t)M * 32 * 4;
constexpr size_t WS_QS = WS_F + (size_t)M * 512 * 4;
constexpr size_t WS_OB = WS_QS + (size_t)M * 512 * 4;
constexpr int HNS = 16, HSEG = SEQ / HNS;
constexpr size_t WS_HS = WS_OB + (size_t)M * 512 * 4;
constexpr size_t WS_HD = WS_HS + (size_t)256 * 512 * 32 * 4;
constexpr size_t WS_CTL = WS_HD + (size_t)256 * 512 * 8 * 4;
constexpr size_t CTL_BYTES = 16384;
constexpr size_t WS_END = WS_CTL + CTL_BYTES;

constexpr int RING_BYTES = 131072;
constexpr int TBL_OFF = RING_BYTES;
constexpr int MISC_OFF = RING_BYTES + 12288;
constexpr int LDS_BYTES = 147456;

__device__ __forceinline__ int otid() { int t = threadIdx.x; asm volatile("" : "+v"(t)); return t; }
__device__ __forceinline__ int obid() { int b = blockIdx.x; asm volatile("" : "+s"(b)); return b; }
template <class T> __device__ __forceinline__ T* optr(T* p) { asm volatile("" : "+s"(p)); return p; }
typedef __bf16 bf16x2_t __attribute__((ext_vector_type(2)));
__device__ __forceinline__ unsigned cvt_pk_bf16(float lo, float hi) { const f32x2 v = {lo, hi}; const bf16x2_t b = __builtin_convertvector(v, bf16x2_t); return __builtin_bit_cast(unsigned, b); }
__device__ __forceinline__ float bf2f(unsigned short h) { return __uint_as_float(((unsigned)h) << 16); }
__device__ __forceinline__ float bflo(unsigned w) { return __uint_as_float(w << 16); }
__device__ __forceinline__ float bfhi(unsigned w) { return __uint_as_float(w & 0xffff0000u); }
__device__ __forceinline__ float fast_rcp(float x) { return __builtin_amdgcn_rcpf(x); }
__device__ __forceinline__ float sigmoidf_(float x) { return fast_rcp(1.f + __expf(-x)); }
__device__ __forceinline__ float siluf_(float x) { return x * sigmoidf_(x); }
__device__ __forceinline__ float wave_sum(float v) {
    v += __int_as_float(__builtin_amdgcn_mov_dpp(__float_as_int(v), 0xB1, 0xF, 0xF, true));
    v += __int_as_float(__builtin_amdgcn_mov_dpp(__float_as_int(v), 0x4E, 0xF, 0xF, true));
    v += __int_as_float(__builtin_amdgcn_mov_dpp(__float_as_int(v), 0x124, 0xF, 0xF, true));
    v += __int_as_float(__builtin_amdgcn_mov_dpp(__float_as_int(v), 0x128, 0xF, 0xF, true));
    const float r0 = __int_as_float(__builtin_amdgcn_readlane(__float_as_int(v), 0)), r1 = __int_as_float(__builtin_amdgcn_readlane(__float_as_int(v), 16));
    const float r2 = __int_as_float(__builtin_amdgcn_readlane(__float_as_int(v), 32)), r3 = __int_as_float(__builtin_amdgcn_readlane(__float_as_int(v), 48));
    return (r0 + r1) + (r2 + r3);
}
__device__ __forceinline__ float gelu_tanh(float v) {
    const float u = 0.7978845608028654f * (v + 0.044715f * v * v * v);
    const float t = 1.f - 2.f * fast_rcp(1.f + __expf(2.f * u));
    return 0.5f * v * (1.f + t);
}

struct RsRegs { f32x4 v[4]; };
namespace pg8 {
constexpr int BM = 256, BK = 64, HALF = 128, HTB = HALF * BK * 2, STAGE_BYTES = 8 * HTB, NXCD = 8, WGM = 8;
__device__ __forceinline__ int lds_byte(int r, int c) { const int st = (r >> 4) * 2 + (c >> 5), rr = r & 15, cc = c & 31, ob = rr * 64 + cc * 2; return st * 1024 + (ob ^ (((ob >> 9) & 1) << 5)); }
__device__ __forceinline__ void stage_rc(int b, int& R, int& C) { const int st = b / 1024, sb = b % 1024, swz = sb ^ (((sb >> 9) & 1) << 5); R = (st >> 1) * 16 + swz / 64; C = (st & 1) * 32 + (swz % 64) / 2; }
__device__ __forceinline__ int perm32(int rho) { const int n = rho >> 4, i = rho & 15; return 8 * (i >> 2) + 4 * n + (i & 3); }

struct Unit { int pm, pn; };
struct Gemm { const bf16_t* A; const bf16_t* Bt; int M, N, K; };

struct StaticOrder {
    int nM, nN, nwg, G, c;
    __device__ void init(int M_, int N_, int G_, int c_) { nM = M_ / BM; nN = N_ / BM; nwg = nM * nN; G = G_; c = c_; }
    __device__ bool next(int i, Unit& u) const {
        const long L = (long)i * G + c; if (L >= nwg) return false;
        int wgid = (int)L; { const int q = nwg / NXCD, r = nwg % NXCD, xcd = wgid % NXCD, off = wgid / NXCD; wgid = (xcd < r ? xcd * (q + 1) : r * (q + 1) + (xcd - r) * q) + off; }
        const int nig = WGM * nN, gid = wgid / nig, fm = gid * WGM, gsz = (nM - fm) < WGM ? (nM - fm) : WGM;
        u.pm = fm + ((wgid % nig) % gsz); u.pn = (wgid % nig) / gsz; return true;
    }
};

template <class Epi>
__device__ __forceinline__ void gemm_phase(LAS unsigned char* lds, const Gemm g, const StaticOrder& S, const Epi& E) {
    const int tid = otid(), wid = __builtin_amdgcn_readfirstlane(tid >> 6), lane = tid & 63, wr = wid >> 2, wc = wid & 3, fr = lane & 15, fq = lane >> 4;
    const int K = g.K, nt = K / BK;
    const char* gA = (const char*)optr(g.A); const char* gB = (const char*)optr(g.Bt);
    unsigned voffA[2], voffB[2];
#pragma unroll
    for (int i = 0; i < 2; ++i) { int R, C; stage_rc(tid * 16 + i * 8192, R, C); const int Rb = Epi::PERM ? ((R & ~31) + perm32(R & 31)) : R;
        voffA[i] = (unsigned)(R * K + C) * 2u; voffB[i] = (unsigned)(Rb * K + C) * 2u; }
    const size_t kstep = (size_t)(BK * 2);
    const size_t hstep = (size_t)HALF * K * 2;
    const size_t tstep = 2 * hstep;
    const unsigned ldsw = (unsigned)wid * 1024u;
    const int aoff = lds_byte(wr * 64 + fr, fq * 8), boff = lds_byte(wc * 32 + fr, fq * 8);
#define PG8_SA(b, h) (((b) * 2 + (h)) * HTB)
#define PG8_SB(b, h) ((4 + (b) * 2 + (h)) * HTB)
#define PG8_STAGE(bufoff, gbase, voff) do { _Pragma("unroll") for (int _i = 0; _i < 2; ++_i) \
        __builtin_amdgcn_global_load_lds((const unsigned*)((const char*)(gbase) + (voff)[_i]), (LAS unsigned*)(lds + (bufoff) + ldsw + _i * 8192), 16, 0, 0); } while (0)
#define PG8_LDA(dst, b, h) do { _Pragma("unroll") for (int m = 0; m < 4; ++m) _Pragma("unroll") for (int k = 0; k < 2; ++k) dst[m][k] = *(const LAS bf16x8*)(lds + PG8_SA(b, h) + aoff + m * 2048 + k * 1024); } while (0)
#define PG8_LDB(dst, b, h) do { _Pragma("unroll") for (int n = 0; n < 2; ++n) _Pragma("unroll") for (int k = 0; k < 2; ++k) dst[n][k] = *(const LAS bf16x8*)(lds + PG8_SB(b, h) + boff + n * 2048 + k * 1024); } while (0)
#define PG8_MMA(ai, bj, At, Bt) do { __builtin_amdgcn_s_setprio(1); _Pragma("unroll") for (int m = 0; m < 4; ++m) _Pragma("unroll") for (int n = 0; n < 2; ++n) _Pragma("unroll") for (int k = 0; k < 2; ++k) \
        acc[ai][bj][m][n] = __builtin_amdgcn_mfma_f32_16x16x32_bf16(Bt[n][k], At[m][k], acc[ai][bj][m][n], 0, 0, 0); __builtin_amdgcn_s_setprio(0); } while (0)
#define PG8_WAIT_V(n) asm volatile("s_waitcnt vmcnt(" #n ")" ::: "memory")
#define PG8_WAIT_L(n) asm volatile("s_waitcnt lgkmcnt(" #n ")" ::: "memory")
#define PG8_BAR __builtin_amdgcn_s_barrier()
#define PG8_SCHED __builtin_amdgcn_sched_barrier(0)
    Unit cur, nxt; int ui = 0;
    if (!S.next(0, cur)) return;
    f32x4 acc[2][2][4][2];
#pragma unroll
    for (int a = 0; a < 2; ++a)
#pragma unroll
        for (int b = 0; b < 2; ++b)
#pragma unroll
            for (int m = 0; m < 4; ++m)
#pragma unroll
                for (int n = 0; n < 2; ++n) acc[a][b][m][n] = (f32x4){0.f, 0.f, 0.f, 0.f};
    bf16x8 At[4][2], B0[2][2], B1[2][2];
    const char* cA = gA + (size_t)cur.pm * tstep; const char* cB = gB + (size_t)cur.pn * tstep;
    RsRegs rsr; E.issue(cur, rsr); E.commit(0, rsr);
    int tsel = 0;
    PG8_STAGE(PG8_SB(0, 0), cB, voffB); PG8_STAGE(PG8_SB(0, 1), cB + hstep, voffB); PG8_STAGE(PG8_SA(0, 0), cA, voffA); PG8_STAGE(PG8_SA(0, 1), cA + hstep, voffA);
    if (wr == 1) PG8_BAR;
    PG8_WAIT_V(2); PG8_BAR;
    PG8_STAGE(PG8_SB(1, 0), cB + kstep, voffB); PG8_STAGE(PG8_SA(1, 0), cA + kstep, voffA); PG8_STAGE(PG8_SB(1, 1), cB + hstep + kstep, voffB);
    PG8_WAIT_V(6); PG8_BAR;
    for (;;) {
        const bool has_next = S.next(ui + 1, nxt);
        const char* nA = has_next ? gA + (size_t)nxt.pm * tstep : cA; const char* nB = has_next ? gB + (size_t)nxt.pn * tstep : cB;
        for (int t = 0; t < nt; t += 2) {
            const bool last = (t == nt - 2);
            const char* a1 = cA + (size_t)(t + 1) * kstep;
            const char* a2 = last ? nA : cA + (size_t)(t + 2) * kstep; const char* b2 = last ? nB : cB + (size_t)(t + 2) * kstep;
            const char* a3 = a2 + kstep; const char* b3 = b2 + kstep;
            const int strict = __builtin_amdgcn_readfirstlane(((t == 0) && (ui > 0)) ? 0 : 1);
#define PG8_WAIT_V8R asm volatile("s_waitcnt vmcnt(16)\n\ts_cmp_eq_u32 %0, 0\n\ts_cbranch_scc1 1f\n\ts_waitcnt vmcnt(8)\n1:" :: "s"(strict) : "scc", "memory")
            PG8_LDB(B0, 0, 0); PG8_LDB(B1, 0, 1); PG8_SCHED; PG8_LDA(At, 0, 0); PG8_STAGE(PG8_SA(1, 1), a1 + hstep, voffA);
            PG8_WAIT_V8R;
            PG8_WAIT_L(0); PG8_BAR; PG8_MMA(0, 0, At, B0); PG8_MMA(0, 1, At, B1); PG8_BAR; PG8_SCHED;
            PG8_LDA(At, 0, 1); PG8_STAGE(PG8_SB(0, 0), b2, voffB); PG8_STAGE(PG8_SB(0, 1), b2 + hstep, voffB); PG8_STAGE(PG8_SA(0, 0), a2, voffA);
            PG8_WAIT_V8R;
            PG8_WAIT_L(0); PG8_BAR; PG8_MMA(1, 0, At, B0); PG8_MMA(1, 1, At, B1); PG8_BAR; PG8_SCHED;
            PG8_LDB(B0, 1, 0); PG8_LDB(B1, 1, 1); PG8_SCHED; PG8_LDA(At, 1, 0); PG8_STAGE(PG8_SA(0, 1), a2 + hstep, voffA);
            PG8_WAIT_V(8); PG8_WAIT_L(0); PG8_BAR; PG8_MMA(0, 0, At, B0); PG8_MMA(0, 1, At, B1); PG8_BAR; PG8_SCHED;
            PG8_LDA(At, 1, 1); PG8_STAGE(PG8_SB(1, 0), b3, voffB); PG8_STAGE(PG8_SB(1, 1), b3 + hstep, voffB); PG8_STAGE(PG8_SA(1, 0), a3, voffA);
            PG8_WAIT_V(8); PG8_WAIT_L(0); PG8_BAR; PG8_MMA(1, 0, At, B0); PG8_MMA(1, 1, At, B1); PG8_BAR; PG8_SCHED;
        }
        if (wr == 0) PG8_BAR;
        const bool newpm = has_next && (nxt.pm != cur.pm);
        if (newpm) E.issue(nxt, rsr);
        E(acc, cur, tsel, wr, wc, fr, fq);
        if (!has_next) break;
#pragma unroll
        for (int a = 0; a < 2; ++a)
#pragma unroll
            for (int b = 0; b < 2; ++b)
#pragma unroll
                for (int m = 0; m < 4; ++m)
#pragma unroll
                    for (int n = 0; n < 2; ++n) acc[a][b][m][n] = (f32x4){0.f, 0.f, 0.f, 0.f};
        cur = nxt; cA = nA; cB = nB; ++ui;
        if (newpm) { tsel ^= 1; E.commit(tsel, rsr); }
        if (wr == 1) PG8_BAR;
    }
    PG8_WAIT_V(0);
    PG8_BAR;
#undef PG8_SA
#undef PG8_SB
#undef PG8_STAGE
#undef PG8_LDA
#undef PG8_LDB
#undef PG8_MMA
#undef PG8_WAIT_V
#undef PG8_WAIT_V8R
#undef PG8_WAIT_L
#undef PG8_BAR
#undef PG8_SCHED
}
}
using pg8::Unit;

struct RsTable {
    const float* ssq; int np; LAS float* tbl;
    __device__ __forceinline__ void issue(const Unit& u, RsRegs& R) const {
        const int t = otid(), row = t >> 1, half = t & 1, hn = np >> 1;
        const float* p = ssq + (size_t)(u.pm * 256 + row) * 32 + half * hn;
        R.v[0] = *(const f32x4*)p; R.v[1] = *(const f32x4*)(p + 4);
        if (hn > 8) { R.v[2] = *(const f32x4*)(p + 8); R.v[3] = *(const f32x4*)(p + 12); } else { R.v[2] = (f32x4){0.f, 0.f, 0.f, 0.f}; R.v[3] = R.v[2]; }
    }
    __device__ __forceinline__ void commit(int ui, const RsRegs& R) const {
        const int t = otid(), row = t >> 1, half = t & 1;
        const f32x4 a = (R.v[0] + R.v[1]) + (R.v[2] + R.v[3]);
        float s = (a.x + a.y) + (a.z + a.w);
        s += __shfl_xor(s, 1);
        if (!half) tbl[(ui & 1) * 256 + row] = rsqrtf(s * (1.f / DM) + EPS);
    }
};

struct EpiSwiglu {
    static constexpr bool PERM = true;
    bf16_t* O; RsTable rt;
    __device__ __forceinline__ void issue(const Unit& u, RsRegs& R) const { rt.issue(u, R); }
    __device__ __forceinline__ void commit(int ui, const RsRegs& R) const { rt.commit(ui, R); }
    __device__ __forceinline__ void operator()(const f32x4 (&acc)[2][2][4][2], const Unit& u, int ui, int wr, int wc, int fr, int fq) const {
        const LAS float* tb = rt.tbl + (ui & 1) * 256;
        const int col0 = u.pn * 128 + wc * 32 + 8 * fq;
#pragma unroll
        for (int ai = 0; ai < 2; ++ai)
#pragma unroll
            for (int m = 0; m < 4; ++m) {
                const int r = ai * 128 + wr * 64 + m * 16 + fr; const float rs = tb[r];
                const float nrl = -1.4426950408889634f * rs, rs2 = rs * rs;
                float o[8];
#pragma unroll
                for (int n = 0; n < 2; ++n)
#pragma unroll
                    for (int j = 0; j < 4; ++j) { const float ag = acc[ai][0][m][n][j], au = acc[ai][1][m][n][j];
                        const float e = __builtin_amdgcn_exp2f(ag * nrl);
                        o[n * 4 + j] = (ag * au) * (fast_rcp(1.f + e) * rs2); }
                u32x4 w; w.x = cvt_pk_bf16(o[0], o[1]); w.y = cvt_pk_bf16(o[2], o[3]); w.z = cvt_pk_bf16(o[4], o[5]); w.w = cvt_pk_bf16(o[6], o[7]);
                *(u32x4*)(O + (size_t)(u.pm * 256 + r) * DFF + col0) = w;
            }
    }
};

struct EpiMixIn {
    static constexpr bool PERM = true;
    bf16_t* P; float* F; float* QS; const float* lbraw; int e; RsTable rt;
    __device__ __forceinline__ void issue(const Unit& u, RsRegs& R) const { rt.issue(u, R); }
    __device__ __forceinline__ void commit(int ui, const RsRegs& R) const { rt.commit(ui, R); }
    __device__ __forceinline__ void operator()(const f32x4 (&acc)[2][2][4][2], const Unit& u, int ui, int wr, int wc, int fr, int fq) const {
        const LAS float* tb = rt.tbl + (ui & 1) * 256;
        const int mode = (u.pn == 5 || u.pn == 6) ? 1 : ((u.pn == 3 || u.pn == 4) ? 2 : 0);
#pragma unroll
        for (int bj = 0; bj < 2; ++bj) {
            const int col0 = u.pn * 256 + bj * 128 + wc * 32 + 8 * fq;
            float lb[8];
#pragma unroll
            for (int j = 0; j < 8; ++j) lb[j] = 0.f;
            if (mode == 1 && e == 1) {
#pragma unroll
                for (int j = 0; j < 8; ++j) { const int c = col0 - 1280 + j; lb[j] = fast_rcp(1.f + __expf(lbraw[c] - lbraw[512 + c])); }
            }
#pragma unroll
            for (int ai = 0; ai < 2; ++ai)
#pragma unroll
                for (int m = 0; m < 4; ++m) {
                    const int r = ai * 128 + wr * 64 + m * 16 + fr; const float rs = tb[r]; const size_t row = (size_t)(u.pm * 256 + r);
                    float v[8];
#pragma unroll
                    for (int n = 0; n < 2; ++n)
#pragma unroll
                        for (int j = 0; j < 4; ++j) v[n * 4 + j] = acc[ai][bj][m][n][j] * rs;
                    if (mode == 0) {
                        u32x4 w; w.x = cvt_pk_bf16(v[0], v[1]); w.y = cvt_pk_bf16(v[2], v[3]); w.z = cvt_pk_bf16(v[4], v[5]); w.w = cvt_pk_bf16(v[6], v[7]);
                        *(u32x4*)(P + row * MIXIN + col0) = w;
                    } else if (mode == 1) {
#pragma unroll
                        for (int j = 0; j < 8; ++j) v[j] = lb[j] + (1.f - lb[j]) * sigmoidf_(v[j]);
                        float* d = F + row * 512 + (col0 - 1280);
                        *(f32x4*)d = (f32x4){v[0], v[1], v[2], v[3]}; *(f32x4*)(d + 4) = (f32x4){v[4], v[5], v[6], v[7]};
                    } else {
#pragma unroll
                        for (int j = 0; j < 8; ++j) v[j] = siluf_(v[j]);
                        float* d = QS + row * 512 + (col0 - 768);
                        *(f32x4*)d = (f32x4){v[0], v[1], v[2], v[3]}; *(f32x4*)(d + 4) = (f32x4){v[4], v[5], v[6], v[7]};
                    }
                }
        }
    }
};

struct EpiResid {
    static constexpr bool PERM = true;
    const float* base32; bf16_t* xb; float* ssq; float alpha;
    __device__ __forceinline__ void issue(const Unit&, RsRegs&) const {}
    __device__ __forceinline__ void commit(int, const RsRegs&) const {}
    __device__ __forceinline__ void operator()(const f32x4 (&acc)[2][2][4][2], const Unit& u, int ui, int wr, int wc, int fr, int fq) const {
        const int col0 = u.pn * 256 + wc * 32 + 8 * fq;
#pragma unroll
        for (int ai = 0; ai < 2; ++ai)
#pragma unroll
            for (int m = 0; m < 4; ++m) {
                const size_t row = (size_t)(u.pm * 256 + ai * 128 + wr * 64 + m * 16 + fr); const size_t off = row * DM + col0;
                f32x4 bs[2][2];
                if (base32) {
#pragma unroll
                    for (int bj = 0; bj < 2; ++bj)
#pragma unroll
                        for (int n = 0; n < 2; ++n) bs[bj][n] = *(const f32x4*)(base32 + off + bj * 128 + n * 4);
                } else {
#pragma unroll
                    for (int bj = 0; bj < 2; ++bj) { const u32x4 w = *(const u32x4*)(xb + off + bj * 128);
                        bs[bj][0] = (f32x4){bflo(w.x), bfhi(w.x), bflo(w.y), bfhi(w.y)}; bs[bj][1] = (f32x4){bflo(w.z), bfhi(w.z), bflo(w.w), bfhi(w.w)}; }
                }
                float s = 0.f;
#pragma unroll
                for (int bj = 0; bj < 2; ++bj) {
                    const f32x4 o0 = bs[bj][0] + acc[ai][bj][m][0] * alpha, o1 = bs[bj][1] + acc[ai][bj][m][1] * alpha;
                    u32x4 w; w.x = cvt_pk_bf16(o0[0], o0[1]); w.y = cvt_pk_bf16(o0[2], o0[3]); w.z = cvt_pk_bf16(o1[0], o1[1]); w.w = cvt_pk_bf16(o1[2], o1[3]);
                    *(u32x4*)(xb + off + bj * 128) = w;
                    s += ((o0[0] * o0[0] + o0[1] * o0[1]) + (o0[2] * o0[2] + o0[3] * o0[3])) + ((o1[0] * o1[0] + o1[1] * o1[1]) + (o1[2] * o1[2] + o1[3] * o1[3]));
                }
                s += __shfl_xor(s, 16); s += __shfl_xor(s, 32);
                if (fq == 0) ssq[row * 32 + u.pn * 4 + wc] = s;
                asm volatile("" ::: "memory");
            }
    }
};

struct EpiGlu {
    static constexpr bool PERM = true;
    bf16_t* xb; float* ssq;
    __device__ __forceinline__ void issue(const Unit&, RsRegs&) const {}
    __device__ __forceinline__ void commit(int, const RsRegs&) const {}
    __device__ __forceinline__ void operator()(const f32x4 (&acc)[2][2][4][2], const Unit& u, int ui, int wr, int wc, int fr, int fq) const {
        const int col0 = u.pn * 128 + wc * 32 + 8 * fq;
#pragma unroll
        for (int ai = 0; ai < 2; ++ai)
#pragma unroll
            for (int m = 0; m < 4; ++m) {
                const size_t row = (size_t)(u.pm * 256 + ai * 128 + wr * 64 + m * 16 + fr); const size_t off = row * DM + col0;
                const u32x4 bw = *(const u32x4*)(xb + off);
                const float b[8] = {bflo(bw.x), bfhi(bw.x), bflo(bw.y), bfhi(bw.y), bflo(bw.z), bfhi(bw.z), bflo(bw.w), bfhi(bw.w)};
                float o[8]; float s = 0.f;
#pragma unroll
                for (int n = 0; n < 2; ++n)
#pragma unroll
                    for (int j = 0; j < 4; ++j) { o[n * 4 + j] = b[n * 4 + j] + acc[ai][0][m][n][j] * sigmoidf_(acc[ai][1][m][n][j]); s += o[n * 4 + j] * o[n * 4 + j]; }
                u32x4 w; w.x = cvt_pk_bf16(o[0], o[1]); w.y = cvt_pk_bf16(o[2], o[3]); w.z = cvt_pk_bf16(o[4], o[5]); w.w = cvt_pk_bf16(o[6], o[7]);
                *(u32x4*)(xb + off) = w;
                s += __shfl_xor(s, 16); s += __shfl_xor(s, 32);
                if (fq == 0) ssq[row * 32 + u.pn * 4 + wc] = s;
                asm volatile("" ::: "memory");
            }
    }
};

struct Params {
    const float *x, *norm_g, *ffn_w_in, *ffn_w_out, *mix_w_in, *attn_sinks, *hgrn_lb, *mix_w_out;
    const float *s5_a_re, *s5_a_im, *s5_log_step, *s5_b_re, *s5_b_im, *s5_c_re, *s5_c_im, *s5_d, *s5_w_glu, *final_g;
    float* out; unsigned char* ws;
};

struct TItem { const float* W; bf16_t* WT; const float* gs; int K, N, ileave, item; };
__device__ __forceinline__ void titem_load(const TItem& t, int lane, f32x4 (&w)[8], float (&gsc)[8]) {
    const int nblk = t.N / 32, kb = t.item / nblk, nb = t.item % nblk, k0 = 64 * kb, n0 = 32 * nb;
#pragma unroll
    for (int i = 0; i < 8; ++i) { const int kk = 8 * i + (lane >> 3); w[i] = *(const f32x4*)(t.W + (size_t)(k0 + kk) * t.N + n0 + 4 * (lane & 7)); gsc[i] = t.gs ? t.gs[k0 + kk] : 1.f; }
}
__device__ __forceinline__ void titem_process(const TItem& t, int lane, LAS float* scr, const f32x4 (&w)[8], const float (&gsc)[8]) {
    const int nblk = t.N / 32, kb = t.item / nblk, nb = t.item % nblk, k0 = 64 * kb, n0 = 32 * nb, K = t.K;
#pragma unroll
    for (int i = 0; i < 8; ++i) { const int kk = 8 * i + (lane >> 3); LAS float* d = scr + kk * 33 + 4 * (lane & 7); const f32x4 v = w[i] * gsc[i]; d[0] = v.x; d[1] = v.y; d[2] = v.z; d[3] = v.w; if ((i & 1) == 1) asm volatile("s_waitcnt lgkmcnt(0)" ::: "memory"); }
    asm volatile("s_waitcnt lgkmcnt(0)" ::: "memory");
    int d0 = n0;
    if (t.ileave) { const int half = t.N >> 1; d0 = (n0 < half) ? ((n0 >> 7) * 256 + (n0 & 127)) : (((n0 - half) >> 7) * 256 + 128 + ((n0 - half) & 127)); }
    const int c = lane & 7;
#pragma unroll
    for (int j = 0; j < 4; ++j) { const int n = (lane >> 3) + 8 * j; const LAS float* s = scr + (8 * c) * 33 + n;
        u32x4 o; o.x = cvt_pk_bf16(s[0 * 33], s[1 * 33]); o.y = cvt_pk_bf16(s[2 * 33], s[3 * 33]); o.z = cvt_pk_bf16(s[4 * 33], s[5 * 33]); o.w = cvt_pk_bf16(s[6 * 33], s[7 * 33]);
        *(u32x4*)(t.WT + (size_t)(d0 + n) * K + k0 + 8 * c) = o; }
    asm volatile("s_waitcnt lgkmcnt(0)" ::: "memory");
}
constexpr int I_FI = (DM / 64) * (2 * DFF / 32), I_FO = (DFF / 64) * (DM / 32), I_MI = (DM / 64) * (MIXIN / 32), I_MO = (DM / 64) * (DM / 32), I_GL = (DM / 64) * (2 * DM / 32);
constexpr int NITEMS = 8 * I_FI + 8 * I_FO + 2 * I_MI + 2 * I_MO + 2 * I_GL;
__device__ __forceinline__ TItem decode_item(const Params& p, int r) {
    unsigned char* ws = p.ws; TItem t;
    if (r < 8 * I_FI) { const int mi = r / I_FI, l = mi >> 1, j = mi & 1;
        t.W = p.ffn_w_in + (size_t)mi * DM * 2 * DFF; t.K = DM; t.N = 2 * DFF; t.WT = (bf16_t*)(ws + WS_WFFN_IN + mi * SZ_WFFN_IN); t.gs = p.norm_g + (size_t)(l * 3 + (j ? 2 : 0)) * DM; t.ileave = 1; t.item = r - mi * I_FI; return t; }
    r -= 8 * I_FI;
    if (r < 8 * I_FO) { const int mi = r / I_FO;
        t.W = p.ffn_w_out + (size_t)mi * DFF * DM; t.K = DFF; t.N = DM; t.WT = (bf16_t*)(ws + WS_WFFN_OUT + mi * SZ_WFFN_OUT); t.gs = nullptr; t.ileave = 0; t.item = r - mi * I_FO; return t; }
    r -= 8 * I_FO;
    if (r < 2 * I_MI) { const int mi = r / I_MI;
        t.W = p.mix_w_in + (size_t)mi * DM * MIXIN; t.K = DM; t.N = MIXIN; t.WT = (bf16_t*)(ws + WS_WMIX_IN + mi * SZ_WMIX_IN); t.gs = p.norm_g + (size_t)((2 * mi) * 3 + 1) * DM; t.ileave = 0; t.item = r - mi * I_MI; return t; }
    r -= 2 * I_MI;
    if (r < 2 * I_MO) { const int mi = r / I_MO;
        t.W = p.mix_w_out + (size_t)mi * DM * DM; t.K = DM; t.N = DM; t.WT = (bf16_t*)(ws + WS_WMIX_OUT + mi * SZ_WMIX_OUT); t.gs = nullptr; t.ileave = 0; t.item = r - mi * I_MO; return t; }
    r -= 2 * I_MO;
    { const int mi = r / I_GL;
        t.W = p.s5_w_glu + (size_t)mi * DM * 2 * DM; t.K = DM; t.N = 2 * DM; t.WT = (bf16_t*)(ws + WS_WGLU + mi * SZ_WGLU); t.gs = nullptr; t.ileave = 1; t.item = r - mi * I_GL; return t; }
}

__device__ __forceinline__ void prologue_phase(const Params& p, LAS unsigned char* lds, int G) {
    const int tid = otid(), lane = tid & 63, wave = __builtin_amdgcn_readfirstlane(tid >> 6);
    LAS float* scr = (LAS float*)(lds + wave * 16384);
    const int gw = obid() * NWAVES + wave, NGW = G * NWAVES;
    unsigned char* ws = p.ws;
    for (int it = gw; it < NITEMS; it += 2 * NGW) {
        const bool hb = it + NGW < NITEMS;
        const TItem a = decode_item(p, it), b = decode_item(p, hb ? it + NGW : it);
        f32x4 wa[8], wb[8]; float ga[8], gb[8];
        titem_load(a, lane, wa, ga); titem_load(b, lane, wb, gb);
        titem_process(a, lane, scr, wa, ga);
        if (hb) titem_process(b, lane, scr, wb, gb);
    }
    bf16_t* xb = (bf16_t*)(ws + WS_XB); float* ssq = (float*)(ws + WS_SSQ);
    for (int m = gw; m < M; m += 2 * NGW) {
        const int m2 = (m + NGW < M) ? (m + NGW) : m;
        const f32x4* xr0 = (const f32x4*)(p.x + (size_t)m * DM) + lane; const f32x4* xr1 = (const f32x4*)(p.x + (size_t)m2 * DM) + lane;
        f32x4 v0[4], v1[4]; float s0 = 0.f, s1 = 0.f;
#pragma unroll
        for (int j = 0; j < 4; ++j) { v0[j] = xr0[64 * j]; v1[j] = xr1[64 * j]; }
#pragma unroll
        for (int j = 0; j < 4; ++j) { s0 += (v0[j].x * v0[j].x + v0[j].y * v0[j].y) + (v0[j].z * v0[j].z + v0[j].w * v0[j].w); s1 += (v1[j].x * v1[j].x + v1[j].y * v1[j].y) + (v1[j].z * v1[j].z + v1[j].w * v1[j].w); }
        s0 = wave_sum(s0); s1 = wave_sum(s1);
        u32x2* o0 = (u32x2*)(xb + (size_t)m * DM) + lane; u32x2* o1 = (u32x2*)(xb + (size_t)m2 * DM) + lane;
#pragma unroll
        for (int j = 0; j < 4; ++j) { u32x2 w; w.x = cvt_pk_bf16(v0[j].x, v0[j].y); w.y = cvt_pk_bf16(v0[j].z, v0[j].w); o0[64 * j] = w;
                                      u32x2 w2; w2.x = cvt_pk_bf16(v1[j].x, v1[j].y); w2.y = cvt_pk_bf16(v1[j].z, v1[j].w); o1[64 * j] = w2; }
        if (lane < 16) { ssq[(size_t)m * 32 + lane] = (lane == 0) ? s0 : 0.f; ssq[(size_t)m2 * 32 + lane] = (lane == 0) ? s1 : 0.f; }
    }
}

constexpr int HQD = 0, HKI = 8704, HKET = 17408, HVT = 27648, HDEC = 37888, HCS = 38400, HPS = 40448;
__device__ __forceinline__ bf16x8 pack8(const f32x4& a, const f32x4& b) {
    u32x4 w; w.x = cvt_pk_bf16(a[0], a[1]); w.y = cvt_pk_bf16(a[2], a[3]); w.z = cvt_pk_bf16(b[0], b[1]); w.w = cvt_pk_bf16(b[2], b[3]); return __builtin_bit_cast(bf16x8, w);
}
__device__ __forceinline__ bf16x8 ld2x8(const LAS bf16_t* p0, const LAS bf16_t* p1) {
    const u32x2 a = *(const LAS u32x2*)p0, b = *(const LAS u32x2*)p1; u32x4 w; w.x = a.x; w.y = a.y; w.z = b.x; w.w = b.y; return __builtin_bit_cast(bf16x8, w);
}
template <bool OUT>
__device__ __forceinline__ void hgrn_mma(const Params& p, int it, LAS unsigned char* lds) {
    const int tid = otid(), lane = tid & 63, wave = __builtin_amdgcn_readfirstlane(tid >> 6), fr = lane & 15, fq = lane >> 4;
    const int b = it >> 6, h = (it >> 4) & 3, seg = it & 15;
    const int dk = tid & 127, tq = tid >> 7;
    LAS bf16_t* Qd = (LAS bf16_t*)(lds + HQD); LAS bf16_t* Ki = (LAS bf16_t*)(lds + HKI); LAS bf16_t* KeT = (LAS bf16_t*)(lds + HKET); LAS bf16_t* VT = (LAS bf16_t*)(lds + HVT);
    LAS float* dec = (LAS float*)(lds + HDEC); LAS float* cs = (LAS float*)(lds + HCS); LAS float* ps = (LAS float*)(lds + HPS);
    const size_t tok0 = (size_t)b * SEQ + (size_t)seg * HSEG;
    const float* Fp = (const float*)(p.ws + WS_F) + tok0 * 512 + h * 128 + dk;
    const float* Qp = (const float*)(p.ws + WS_QS) + tok0 * 512 + h * 128 + dk;
    const bf16_t* proj = (const bf16_t*)(p.ws + WS_ACT);
    const bf16_t* Vp = proj + tok0 * MIXIN + 1792 + h * 128 + dk;
    bf16_t* cat = (bf16_t*)(p.ws + WS_CAT);
    f32x4* HS4 = (f32x4*)(p.ws + WS_HS); float* HD = (float*)(p.ws + WS_HD);
    f32x4 S[8];
#pragma unroll
    for (int mb = 0; mb < 8; ++mb) S[mb] = (f32x4){0.f, 0.f, 0.f, 0.f};
    if (OUT) {
        f32x4 Pd[8];
#pragma unroll
        for (int mb = 0; mb < 8; ++mb) Pd[mb] = (f32x4){1.f, 1.f, 1.f, 1.f};
#pragma unroll 2
        for (int v = seg - 1; v >= 0; --v) { const int itv = it - seg + v;
#pragma unroll
            for (int mb = 0; mb < 8; ++mb) { const f32x4 x = HS4[(((size_t)itv * 8 + wave) * 8 + mb) * 64 + lane]; const f32x4 d4 = *(const f32x4*)(HD + (size_t)itv * 128 + mb * 16 + fq * 4);
                S[mb] = S[mb] + Pd[mb] * x; Pd[mb] = Pd[mb] * d4; } }
    }
    float dlog = 0.f;
    const int dvrow = wave * 16 + fr;
    const bf16_t* Gp = proj + tok0 * MIXIN + 2304 + h * 128 + wave * 16 + fq * 4;
    float fvA[8], qvA[8], fvB[8], qvB[8]; unsigned short vvA[8], vvB[8]; u32x2 gA0, gA1, gB0, gB1;
#define HG_LOAD(fv, qv, vv, g0, g1, cc) do { const int c_ = (cc) < (HSEG / 32) ? (cc) : (HSEG / 32 - 1); \
        _Pragma("unroll") for (int r = 0; r < 8; ++r) { const size_t t = (size_t)(c_ * 32 + tq * 8 + r); fv[r] = Fp[t * 512]; if (OUT) qv[r] = Qp[t * 512]; vv[r] = Vp[t * MIXIN]; } \
        if (OUT) { g0 = *(const u32x2*)(Gp + (size_t)(c_ * 32 + fr) * MIXIN); g1 = *(const u32x2*)(Gp + (size_t)(c_ * 32 + 16 + fr) * MIXIN); } } while (0)
#define HG_CHUNK(fv, qv, vv, g0, g1, c) do { \
        float cum[8]; float run = 0.f; \
        _Pragma("unroll") for (int r = 0; r < 8; ++r) { run += __logf(fv[r]); cum[r] = run; } \
        if (OUT && (c) > 0) { *(u32x2*)(cat + ptok * DM + 512 + h * 128 + wave * 16 + fq * 4) = pwA; *(u32x2*)(cat + (ptok + 16) * DM + 512 + h * 128 + wave * 16 + fq * 4) = pwB; } \
        cs[tq * 128 + dk] = run; \
        asm volatile("s_waitcnt lgkmcnt(0)" ::: "memory"); __builtin_amdgcn_s_barrier(); asm volatile("" ::: "memory");        \
        float off = 0.f, tot = 0.f; \
        _Pragma("unroll") for (int q = 0; q < 4; ++q) { const float x = cs[q * 128 + dk]; tot += x; if (q < tq) off += x; } \
        float ke[8]; \
        _Pragma("unroll") for (int r = 0; r < 8; ++r) { const float cm = cum[r] + off, k = 1.f - fv[r]; const int t = tq * 8 + r; \
            if (OUT) { Qd[t * 136 + dk] = (bf16_t)(cvt_pk_bf16(qv[r] * __expf(cm), 0.f) & 0xffffu); Ki[t * 136 + dk] = (bf16_t)(cvt_pk_bf16(k * __expf(-cm), 0.f) & 0xffffu); } \
            ke[r] = k * __expf(tot - cm); if ((r & 3) == 3) asm volatile("s_waitcnt lgkmcnt(0)" ::: "memory"); } \
        { u32x4 w; w.x = cvt_pk_bf16(ke[0], ke[1]); w.y = cvt_pk_bf16(ke[2], ke[3]); w.z = cvt_pk_bf16(ke[4], ke[5]); w.w = cvt_pk_bf16(ke[6], ke[7]); *(LAS u32x4*)(KeT + dk * 40 + tq * 8) = w; } \
        { u32x4 w; w.x = (unsigned)vv[0] | ((unsigned)vv[1] << 16); w.y = (unsigned)vv[2] | ((unsigned)vv[3] << 16); w.z = (unsigned)vv[4] | ((unsigned)vv[5] << 16); w.w = (unsigned)vv[6] | ((unsigned)vv[7] << 16); \
          *(LAS u32x4*)(VT + dk * 40 + tq * 8) = w; } \
        if (tq == 0) { dec[dk] = __expf(tot); dlog += tot; } \
        const u32x2 gc0 = g0, gc1 = g1; \
        HG_LOAD(fv, qv, vv, g0, g1, (c) + 2);                                                                                    \
        asm volatile("s_waitcnt lgkmcnt(0)" ::: "memory"); __builtin_amdgcn_s_barrier(); asm volatile("" ::: "memory");        \
        f32x4 o0 = (f32x4){0.f, 0.f, 0.f, 0.f}, o1 = o0; \
        if (OUT) { \
            f32x4 sc00 = o0, sc01 = o0, sc11 = o0; \
            _Pragma("unroll") for (int ks = 0; ks < 4; ++ks) { \
                const bf16x8 a0 = *(const LAS bf16x8*)(Ki + fr * 136 + ks * 32 + fq * 8), a1 = *(const LAS bf16x8*)(Ki + (16 + fr) * 136 + ks * 32 + fq * 8); \
                const bf16x8 b0 = *(const LAS bf16x8*)(Qd + fr * 136 + ks * 32 + fq * 8), b1 = *(const LAS bf16x8*)(Qd + (16 + fr) * 136 + ks * 32 + fq * 8); \
                sc00 = __builtin_amdgcn_mfma_f32_16x16x32_bf16(a0, b0, sc00, 0, 0, 0); \
                sc01 = __builtin_amdgcn_mfma_f32_16x16x32_bf16(a0, b1, sc01, 0, 0, 0); \
                sc11 = __builtin_amdgcn_mfma_f32_16x16x32_bf16(a1, b1, sc11, 0, 0, 0); asm volatile("s_waitcnt lgkmcnt(0)" ::: "memory"); } \
            _Pragma("unroll") for (int j = 0; j < 4; ++j) if (fq * 4 + j > fr) { sc00[j] = 0.f; sc11[j] = 0.f; } \
            const bf16x8 Pb0 = pack8(sc00, (f32x4){0.f, 0.f, 0.f, 0.f}), Pb1 = pack8(sc01, sc11); \
            const bf16x8 Va = ld2x8(VT + dvrow * 40 + fq * 4, VT + dvrow * 40 + 16 + fq * 4); \
            f32x4 o0b = o0, o1b = o0; \
            o0 = __builtin_amdgcn_mfma_f32_16x16x32_bf16(Va, Pb0, o0, 0, 0, 0); \
            o1 = __builtin_amdgcn_mfma_f32_16x16x32_bf16(Va, Pb1, o1, 0, 0, 0); \
            _Pragma("unroll") for (int ks = 0; ks < 4; ++ks) { \
                const bf16x8 Sa = pack8(S[2 * ks], S[2 * ks + 1]); \
                const bf16x8 q0 = ld2x8(Qd + fr * 136 + (2 * ks) * 16 + fq * 4, Qd + fr * 136 + (2 * ks + 1) * 16 + fq * 4); \
                const bf16x8 q1 = ld2x8(Qd + (16 + fr) * 136 + (2 * ks) * 16 + fq * 4, Qd + (16 + fr) * 136 + (2 * ks + 1) * 16 + fq * 4); \
                if (ks & 1) { o0b = __builtin_amdgcn_mfma_f32_16x16x32_bf16(Sa, q0, o0b, 0, 0, 0); o1b = __builtin_amdgcn_mfma_f32_16x16x32_bf16(Sa, q1, o1b, 0, 0, 0); } \
                else { o0 = __builtin_amdgcn_mfma_f32_16x16x32_bf16(Sa, q0, o0, 0, 0, 0); o1 = __builtin_amdgcn_mfma_f32_16x16x32_bf16(Sa, q1, o1, 0, 0, 0); } asm volatile("s_waitcnt lgkmcnt(0)" ::: "memory"); } \
            o0 = o0 + o0b; o1 = o1 + o1b; \
        } \
        {     \
            const bf16x8 vb = *(const LAS bf16x8*)(VT + dvrow * 40 + fq * 8); \
            _Pragma("unroll") for (int mb = 0; mb < 8; ++mb) { const f32x4 d4 = *(const LAS f32x4*)(dec + mb * 16 + fq * 4); const bf16x8 ka = *(const LAS bf16x8*)(KeT + (mb * 16 + fr) * 40 + fq * 8); \
                S[mb] = __builtin_amdgcn_mfma_f32_16x16x32_bf16(ka, vb, S[mb] * d4, 0, 0, 0); if (mb & 1) asm volatile("s_waitcnt lgkmcnt(0)" ::: "memory"); } \
        } \
        if (OUT) { \
            const size_t tokA = tok0 + (size_t)(c) * 32 + fr, tokB = tokA + 16; \
            float pp0 = (o0[0] * o0[0] + o0[1] * o0[1]) + (o0[2] * o0[2] + o0[3] * o0[3]), pp1 = (o1[0] * o1[0] + o1[1] * o1[1]) + (o1[2] * o1[2] + o1[3] * o1[3]); \
            pp0 += __shfl_xor(pp0, 16); pp0 += __shfl_xor(pp0, 32); pp1 += __shfl_xor(pp1, 16); pp1 += __shfl_xor(pp1, 32); \
            if (fq == 0) { ps[wave * 32 + fr] = pp0; ps[wave * 32 + 16 + fr] = pp1; } \
            asm volatile("s_waitcnt lgkmcnt(0)" ::: "memory"); __builtin_amdgcn_s_barrier(); asm volatile("" ::: "memory");    \
            float s0 = 0.f, s1 = 0.f; \
            _Pragma("unroll") for (int w = 0; w < 8; ++w) { s0 += ps[w * 32 + fr]; s1 += ps[w * 32 + 16 + fr]; } \
            const float rn0 = rsqrtf(s0 * (1.f / 128.f) + EPS), rn1 = rsqrtf(s1 * (1.f / 128.f) + EPS); \
            u32x2 wA, wB; \
            wA.x = cvt_pk_bf16(o0[0] * rn0 * siluf_(bflo(gc0.x)), o0[1] * rn0 * siluf_(bfhi(gc0.x))); wA.y = cvt_pk_bf16(o0[2] * rn0 * siluf_(bflo(gc0.y)), o0[3] * rn0 * siluf_(bfhi(gc0.y))); \
            wB.x = cvt_pk_bf16(o1[0] * rn1 * siluf_(bflo(gc1.x)), o1[1] * rn1 * siluf_(bfhi(gc1.x))); wB.y = cvt_pk_bf16(o1[2] * rn1 * siluf_(bflo(gc1.y)), o1[3] * rn1 * siluf_(bfhi(gc1.y))); \
            pwA = wA; pwB = wB; ptok = tokA; (void)tokB;        \
        } } while (0)
    u32x2 pwA = {0u, 0u}, pwB = {0u, 0u}; size_t ptok = 0;
    HG_LOAD(fvA, qvA, vvA, gA0, gA1, 0);
    HG_LOAD(fvB, qvB, vvB, gB0, gB1, 1);
#pragma unroll 1
    for (int c = 0; c < HSEG / 32; c += 2) {
        HG_CHUNK(fvA, qvA, vvA, gA0, gA1, c);
        HG_CHUNK(fvB, qvB, vvB, gB0, gB1, c + 1);
    }
    if (OUT) { *(u32x2*)(cat + ptok * DM + 512 + h * 128 + wave * 16 + fq * 4) = pwA; *(u32x2*)(cat + (ptok + 16) * DM + 512 + h * 128 + wave * 16 + fq * 4) = pwB; }
#undef HG_LOAD
#undef HG_CHUNK
    if (!OUT) {
#pragma unroll
        for (int mb = 0; mb < 8; ++mb) HS4[(((size_t)it * 8 + wave) * 8 + mb) * 64 + lane] = S[mb];
        if (tq == 0) HD[(size_t)it * 128 + dk] = __expf(dlog);
    }
    __syncthreads();
}


constexpr int AKS = 72, AVS = 268;
constexpr int AK_OFF = 0, AV_OFF = 256 * AKS * 2;
__device__ __forceinline__ void attn_mma(const Params& p, int e, LAS unsigned char* lds, int G) {
    const int tid = otid(), lane = tid & 63, wave = __builtin_amdgcn_readfirstlane(tid >> 6), fr = lane & 15, fq = lane >> 4;
    LAS bf16_t* Ks = (LAS bf16_t*)(lds + AK_OFF); LAS bf16_t* VTs = (LAS bf16_t*)(lds + AV_OFF);
    const bf16_t* P = (const bf16_t*)(p.ws + WS_ACT); bf16_t* cat = (bf16_t*)(p.ws + WS_CAT);
    const int g = wave >> 1, half = wave & 1;
    for (int item = obid(); item < 512; item += G) {
        const int kvh = item & 1, nbi = (item >> 1) & 63, b = item >> 7, hq = kvh * 4 + g;
        const size_t tokblk = (size_t)b * SEQ + (size_t)nbi * 128;
        const bf16_t* qsrc = P + (tokblk + half * 64 + fr) * MIXIN + hq * 64 + fq * 8;
        bf16x8 qn0 = *(const bf16x8*)qsrc, qn1 = *(const bf16x8*)(qsrc + 32);
#pragma unroll
        for (int i = 0; i < 4; ++i) {
            const int id = tid + 512 * i, row = id >> 3, ch = id & 7;
            int tk = nbi * 128 - 128 + row; if (tk < 0) tk = 0;
            const bf16_t* src = P + ((size_t)b * SEQ + tk) * MIXIN + 512 + kvh * 64 + ch * 8;
            const u32x4 kq = *(const u32x4*)src, vq = *(const u32x4*)(src + 128);
            *(LAS u32x4*)(Ks + row * AKS + ch * 8) = kq;
            LAS bf16_t* vd = VTs + (ch * 8) * AVS + row;
            vd[0 * AVS] = (bf16_t)(vq.x & 0xffffu); vd[1 * AVS] = (bf16_t)(vq.x >> 16); vd[2 * AVS] = (bf16_t)(vq.y & 0xffffu); vd[3 * AVS] = (bf16_t)(vq.y >> 16);
            vd[4 * AVS] = (bf16_t)(vq.z & 0xffffu); vd[5 * AVS] = (bf16_t)(vq.z >> 16); vd[6 * AVS] = (bf16_t)(vq.w & 0xffffu); vd[7 * AVS] = (bf16_t)(vq.w >> 16);
            asm volatile("s_waitcnt lgkmcnt(0)" ::: "memory");
        }
        asm volatile("s_waitcnt lgkmcnt(0)" ::: "memory"); __builtin_amdgcn_s_barrier(); asm volatile("" ::: "memory");
        const float slope = exp2f(-(float)(hq + 1)), sink = p.attn_sinks[e * 8 + hq];
#pragma unroll 1
        for (int rb4 = 0; rb4 < 4; ++rb4) {
            const int rbase = half * 64 + rb4 * 16, rb = rbase >> 4, irow = rbase + fr;
            const bf16x8 q0 = qn0, q1 = qn1;
            { const int rn = rb4 < 3 ? rb4 + 1 : 3; qn0 = *(const bf16x8*)(qsrc + (size_t)rn * 16 * MIXIN); qn1 = *(const bf16x8*)(qsrc + (size_t)rn * 16 * MIXIN + 32); }
            f32x4 sc[10];
#pragma unroll
            for (int kbi = 0; kbi < 10; ++kbi) {
                const int kb = (rb + kbi) < 15 ? (rb + kbi) : 15;
                const bf16x8 a0 = *(const LAS bf16x8*)(Ks + (kb * 16 + fr) * AKS + fq * 8), a1 = *(const LAS bf16x8*)(Ks + (kb * 16 + fr) * AKS + 32 + fq * 8);
                f32x4 r = __builtin_amdgcn_mfma_f32_16x16x32_bf16(a0, q0, (f32x4){0.f, 0.f, 0.f, 0.f}, 0, 0, 0);
                sc[kbi] = __builtin_amdgcn_mfma_f32_16x16x32_bf16(a1, q1, r, 0, 0, 0);
                if (kbi & 1) asm volatile("s_waitcnt lgkmcnt(0)" ::: "memory");
            }
            float mx = sink;
#pragma unroll
            for (int kbi = 0; kbi < 10; ++kbi)
#pragma unroll
                for (int jj = 0; jj < 4; ++jj) {
                    const int j = (rb + kbi) * 16 + fq * 4 + jj, dist = irow + 128 - j;
                    const bool valid = (dist >= 0) && (dist < 128) && (nbi > 0 || j >= 128);
                    const float sv = valid ? (sc[kbi][jj] * 0.125f - slope * (float)dist) : -INFINITY;
                    sc[kbi][jj] = sv; mx = fmaxf(mx, sv);
                }
            mx = fmaxf(mx, __shfl_xor(mx, 16)); mx = fmaxf(mx, __shfl_xor(mx, 32));
            float l = 0.f;
#pragma unroll
            for (int kbi = 0; kbi < 10; ++kbi)
#pragma unroll
                for (int jj = 0; jj < 4; ++jj) { const float pv = __expf(sc[kbi][jj] - mx); sc[kbi][jj] = pv; l += pv; }
            l += __shfl_xor(l, 16); l += __shfl_xor(l, 32); l += __expf(sink - mx);
            f32x4 O[4];
#pragma unroll
            for (int db = 0; db < 4; ++db) O[db] = (f32x4){0.f, 0.f, 0.f, 0.f};
#pragma unroll
            for (int pi = 0; pi < 5; ++pi) {
                const int kb0 = (rb + 2 * pi) < 15 ? (rb + 2 * pi) : 15, kb1 = (rb + 2 * pi + 1) < 15 ? (rb + 2 * pi + 1) : 15;
                const bf16x8 Pb = pack8(sc[2 * pi], sc[2 * pi + 1]);
#pragma unroll
                for (int db = 0; db < 4; ++db) {
                    const bf16x8 Va = ld2x8(VTs + (db * 16 + fr) * AVS + kb0 * 16 + fq * 4, VTs + (db * 16 + fr) * AVS + kb1 * 16 + fq * 4);
                    O[db] = __builtin_amdgcn_mfma_f32_16x16x32_bf16(Va, Pb, O[db], 0, 0, 0);
                }
                asm volatile("s_waitcnt lgkmcnt(0)" ::: "memory");
            }
            const float inv = fast_rcp(l);
            bf16_t* op = cat + (tokblk + irow) * DM + hq * 64 + fq * 4;
#pragma unroll
            for (int db = 0; db < 4; ++db) { u32x2 w; w.x = cvt_pk_bf16(O[db][0] * inv, O[db][1] * inv); w.y = cvt_pk_bf16(O[db][2] * inv, O[db][3] * inv); *(u32x2*)(op + db * 16) = w; }
        }
        asm volatile("s_waitcnt lgkmcnt(0)" ::: "memory"); __builtin_amdgcn_s_barrier(); asm volatile("" ::: "memory");
    }
}

constexpr int S5_SEG = SEQ / NWAVES;
__device__ __forceinline__ void s5_phase(const Params& p, int layer, int oi, LAS unsigned char* lds, int G) {
    const int tid = otid(), lane = tid & 63, wave = __builtin_amdgcn_readfirstlane(tid >> 6);
    LAS unsigned char* wl = lds + wave * 16384;
    LAS bf16_t* U_bf = (LAS bf16_t*)wl;
    LAS float* U_f = (LAS float*)(wl + 1024);
    LAS float* BU = (LAS float*)(wl + 2048);
    LAS bf16_t* XH = (LAS bf16_t*)(wl + 2048 + 8448);
    LAS float* XCH = (LAS float*)(lds + TBL_OFF + 2048);
    const bf16_t* X = (const bf16_t*)(p.ws + WS_XB); const float* ssq = (const float*)(p.ws + WS_SSQ); bf16_t* yb = (bf16_t*)(p.ws + WS_CAT);
    const int fr = lane & 15, fq = lane >> 4;
    const int bid_ = obid(), vb_ = (G % 8 == 0) ? (bid_ % 8) * (G / 8) + bid_ / 8 : bid_;
    for (int item = vb_; item < BATCH * 64; item += G) {
        const int b = item >> 6, g = item & 63;
        const size_t gp = ((size_t)oi * 64 + g) * 64 + lane;
        const float lr = p.s5_a_re[gp], li = p.s5_a_im[gp];
        const float step = __expf(p.s5_log_step[oi * 64 + g]);
        const float mag = expf(step * lr);
        float sn, cs; sincosf(step * li, &sn, &cs);
        const float abr = mag * cs, abi = mag * sn;
        const float den = lr * lr + li * li;
        const float cfr = ((abr - 1.f) * lr + abi * li) / den, cfi = (abi * lr - (abr - 1.f) * li) / den;
        {
            LAS bf16_t* BBm = (LAS bf16_t*)BU;
            const f32x4* brp = (const f32x4*)(p.s5_b_re + gp * 16); const f32x4* bip = (const f32x4*)(p.s5_b_im + gp * 16);
            unsigned wr_[8], wi_[8];
#pragma unroll
            for (int c4 = 0; c4 < 4; ++c4) { const f32x4 br = brp[c4], bi = bip[c4];
                float r_[4], i_[4];
#pragma unroll
                for (int j = 0; j < 4; ++j) { r_[j] = cfr * br[j] - cfi * bi[j]; i_[j] = cfr * bi[j] + cfi * br[j]; }
                wr_[c4 * 2] = cvt_pk_bf16(r_[0], r_[1]); wr_[c4 * 2 + 1] = cvt_pk_bf16(r_[2], r_[3]); wi_[c4 * 2] = cvt_pk_bf16(i_[0], i_[1]); wi_[c4 * 2 + 1] = cvt_pk_bf16(i_[2], i_[3]); }
            LAS u32x4* rr = (LAS u32x4*)(BBm + lane * 32); LAS u32x4* ri = (LAS u32x4*)(BBm + (64 + lane) * 32);
            rr[0] = (u32x4){wr_[0], wr_[1], wr_[2], wr_[3]}; rr[1] = (u32x4){wr_[4], wr_[5], wr_[6], wr_[7]}; rr[2] = (u32x4){0u, 0u, 0u, 0u}; rr[3] = (u32x4){0u, 0u, 0u, 0u}; asm volatile("s_waitcnt lgkmcnt(0)" ::: "memory");
            ri[0] = (u32x4){wi_[0], wi_[1], wi_[2], wi_[3]}; ri[1] = (u32x4){wi_[4], wi_[5], wi_[6], wi_[7]}; ri[2] = (u32x4){0u, 0u, 0u, 0u}; ri[3] = (u32x4){0u, 0u, 0u, 0u};
            asm volatile("" ::: "memory");
        }
        bf16x8 Bop[8], Cop[4];
#pragma unroll
        for (int nb = 0; nb < 8; ++nb) Bop[nb] = *(const LAS bf16x8*)((LAS bf16_t*)BU + (nb * 16 + fr) * 32 + fq * 8);
#pragma unroll
        for (int ks = 0; ks < 4; ++ks) {
            const float* src = ((ks < 2) ? p.s5_c_re : p.s5_c_im) + (((size_t)oi * 64 + g) * 16 + fr) * 64 + (ks & 1) * 32 + fq * 8;
            const f32x4 a = *(const f32x4*)src, c = *(const f32x4*)(src + 4); const float sg = (ks < 2) ? 1.f : -1.f;
            u32x4 w; w.x = cvt_pk_bf16(sg * a[0], sg * a[1]); w.y = cvt_pk_bf16(sg * a[2], sg * a[3]); w.z = cvt_pk_bf16(sg * c[0], sg * c[1]); w.w = cvt_pk_bf16(sg * c[2], sg * c[3]);
            Cop[ks] = __builtin_bit_cast(bf16x8, w);
        }
        const float dsk = p.s5_d[oi * DM + g * 16 + fr];
        const int ut = lane >> 2, ucq = lane & 3;
        const f32x4 gn4 = *(const f32x4*)(p.norm_g + (size_t)(layer * 3 + 1) * DM + g * 16 + ucq * 4);
        asm volatile("s_waitcnt lgkmcnt(0)" ::: "memory");
        { LAS u32x4* z = (LAS u32x4*)U_bf; z[lane] = (u32x4){0u, 0u, 0u, 0u}; } asm volatile("" ::: "memory");
        const size_t tokbase = (size_t)b * SEQ + (size_t)wave * S5_SEG;
        float xr = 0.f, xi = 0.f;
        bf16_t yprev[4] = {0, 0, 0, 0};
#pragma unroll 1
        for (int pass = 0; pass < 2; ++pass) {
            u32x2 xn = *(const u32x2*)(X + (tokbase + ut) * DM + g * 16 + ucq * 4);
            f32x4 sq = *(const f32x4*)(ssq + (tokbase + ut) * 32 + ucq * 4);
#pragma unroll 1
            for (int t0 = 0; t0 < S5_SEG; t0 += 16) {
                const f32x4 xc = (f32x4){bflo(xn.x), bfhi(xn.x), bflo(xn.y), bfhi(xn.y)}, sc = sq;
                { const int tn = (t0 + 16 < S5_SEG) ? (t0 + 16) : t0;
                  xn = *(const u32x2*)(X + (tokbase + tn + ut) * DM + g * 16 + ucq * 4); sq = *(const f32x4*)(ssq + (tokbase + tn + ut) * 32 + ucq * 4); }
                if (pass && t0 > 0) {
#pragma unroll
                    for (int j = 0; j < 4; ++j) yb[(tokbase + t0 - 16 + fq * 4 + j) * DM + g * 16 + fr] = yprev[j];
                }
                float s = (sc.x + sc.y) + (sc.z + sc.w);
                s += __int_as_float(__builtin_amdgcn_mov_dpp(__float_as_int(s), 0xB1, 0xF, 0xF, true));
                s += __int_as_float(__builtin_amdgcn_mov_dpp(__float_as_int(s), 0x4E, 0xF, 0xF, true));
                const float rs = rsqrtf(s * (1.f / DM) + EPS);
                const f32x4 u4 = xc * rs * gn4;
                *(LAS f32x4*)(U_f + ut * 16 + ucq * 4) = u4;
                { u32x2 w; w.x = cvt_pk_bf16(u4[0], u4[1]); w.y = cvt_pk_bf16(u4[2], u4[3]); *(LAS u32x2*)(U_bf + ut * 32 + ucq * 4) = w; } asm volatile("" ::: "memory");
                const bf16x8 ua = *(const LAS bf16x8*)(U_bf + fr * 32 + fq * 8);
#pragma unroll
                for (int nb = 0; nb < 8; ++nb) {
                    f32x4 r = __builtin_amdgcn_mfma_f32_16x16x32_bf16(ua, Bop[nb], (f32x4){0.f, 0.f, 0.f, 0.f}, 0, 0, 0);
#pragma unroll
                    for (int j = 0; j < 4; ++j) BU[(fq * 4 + j) * 132 + nb * 16 + fr] = r[j];
                } asm volatile("" ::: "memory");
                float br_[16], bi_[16];
#pragma unroll
                for (int tt = 0; tt < 16; ++tt) { br_[tt] = BU[tt * 132 + lane]; bi_[tt] = BU[tt * 132 + 64 + lane]; if ((tt & 7) == 7) asm volatile("s_waitcnt lgkmcnt(0)" ::: "memory"); }
#pragma unroll
                for (int tt = 0; tt < 16; ++tt) {
                    const float bur = br_[tt], bui = bi_[tt];
                    const float nxr = abr * xr - abi * xi + bur, nxi = abr * xi + abi * xr + bui;
                    xr = nxr; xi = nxi;
                    if (pass) { XH[tt * 136 + lane] = (bf16_t)(cvt_pk_bf16(xr, 0.f) & 0xffffu); XH[tt * 136 + 64 + lane] = (bf16_t)(cvt_pk_bf16(xi, 0.f) & 0xffffu); }
                } asm volatile("" ::: "memory");
                if (pass) {
                    f32x4 y = (f32x4){0.f, 0.f, 0.f, 0.f};
#pragma unroll
                    for (int ks = 0; ks < 4; ++ks) { const bf16x8 xa = *(const LAS bf16x8*)(XH + fr * 136 + ks * 32 + fq * 8); y = __builtin_amdgcn_mfma_f32_16x16x32_bf16(xa, Cop[ks], y, 0, 0, 0); }
#pragma unroll
                    for (int j = 0; j < 4; ++j) { const int t = fq * 4 + j; const float v = gelu_tanh(y[j] + dsk * U_f[t * 16 + fr]);
                        yprev[j] = (bf16_t)(cvt_pk_bf16(v, 0.f) & 0xffffu); }
                } asm volatile("" ::: "memory");
            }
            if (pass) {
#pragma unroll
                for (int j = 0; j < 4; ++j) yb[(tokbase + S5_SEG - 16 + fq * 4 + j) * DM + g * 16 + fr] = yprev[j];
            }
            if (pass == 0) {
                XCH[(wave * 64 + lane) * 2] = xr; XCH[(wave * 64 + lane) * 2 + 1] = xi;
                float pr = abr, pi = abi;
#pragma unroll
                for (int q = 0; q < 10; ++q) { const float nr = pr * pr - pi * pi, ni = 2.f * pr * pi; pr = nr; pi = ni; }
                __syncthreads();
                float sr = 0.f, si = 0.f;
                for (int v = 0; v < wave; ++v) { const float er = XCH[(v * 64 + lane) * 2], ei = XCH[(v * 64 + lane) * 2 + 1];
                    const float nr = pr * sr - pi * si + er, ni = pr * si + pi * sr + ei; sr = nr; si = ni; }
                xr = sr; xi = si;
            }
        }
        __syncthreads();
    }
}

__device__ __forceinline__ void final_norm(const Params& p, int G) {
    const int tid = otid(), lane = tid & 63, wave = tid >> 6;
    const int gw = obid() * NWAVES + wave, NGW = G * NWAVES;
    const bf16_t* xb = (const bf16_t*)(p.ws + WS_XB);
    f32x4 gv[4];
#pragma unroll
    for (int j = 0; j < 4; ++j) gv[j] = ((const f32x4*)p.final_g)[lane + 64 * j];
    for (int m = gw; m < M; m += 2 * NGW) {
        const int m2 = (m + NGW < M) ? (m + NGW) : m;
        const u32x2* xr0 = (const u32x2*)(xb + (size_t)m * DM) + lane; const u32x2* xr1 = (const u32x2*)(xb + (size_t)m2 * DM) + lane;
        u32x2 w0[4], w1[4];
#pragma unroll
        for (int j = 0; j < 4; ++j) { w0[j] = xr0[64 * j]; w1[j] = xr1[64 * j]; }
        f32x4 v0[4], v1[4]; float s0 = 0.f, s1 = 0.f;
#pragma unroll
        for (int j = 0; j < 4; ++j) {
            v0[j] = (f32x4){bflo(w0[j].x), bfhi(w0[j].x), bflo(w0[j].y), bfhi(w0[j].y)}; v1[j] = (f32x4){bflo(w1[j].x), bfhi(w1[j].x), bflo(w1[j].y), bfhi(w1[j].y)};
            s0 += (v0[j].x * v0[j].x + v0[j].y * v0[j].y) + (v0[j].z * v0[j].z + v0[j].w * v0[j].w); s1 += (v1[j].x * v1[j].x + v1[j].y * v1[j].y) + (v1[j].z * v1[j].z + v1[j].w * v1[j].w); }
        const float rs0 = rsqrtf(wave_sum(s0) * (1.f / DM) + EPS), rs1 = rsqrtf(wave_sum(s1) * (1.f / DM) + EPS);
        f32x4* o0 = (f32x4*)(p.out + (size_t)m * DM) + lane; f32x4* o1 = (f32x4*)(p.out + (size_t)m2 * DM) + lane;
#pragma unroll
        for (int j = 0; j < 4; ++j) { o0[64 * j] = v0[j] * rs0 * gv[j]; o1[64 * j] = v1[j] * rs1 * gv[j]; }
    }
}

#define XB_TMO      128
#define XB_XCNT(j)  (256  + 64 * (j))
#define XB_XSUB(j)  (1280 + 64 * (j))
#define XB_XGEN(j)  (2304 + 64 * (j))
#define XB_TOP      3328
#define XB_TOPGEN   3392
#define XCD_BAR_WORDS 3456
#define XB_SPIN_CAP (1u << 18)
__device__ __forceinline__ unsigned xb_ld(unsigned* p)              { return __hip_atomic_load(p, __ATOMIC_RELAXED, __HIP_MEMORY_SCOPE_AGENT); }
__device__ __forceinline__ unsigned xb_add(unsigned* p, unsigned v) { return __hip_atomic_fetch_add(p, v, __ATOMIC_RELAXED, __HIP_MEMORY_SCOPE_AGENT); }
__device__ __forceinline__ unsigned xb_xcc_id() { return (unsigned)__builtin_amdgcn_s_getreg((3 << 11) | 20) & 0xFu; }
#define XB_SPIN(cond, bar) do { unsigned _sp = 0; while (cond) { __builtin_amdgcn_s_sleep(1); \
    if ((++_sp & 255u) == 0u) { if (xb_ld(&(bar)[XB_TMO])) break; if (_sp > XB_SPIN_CAP) { atomicAdd(&(bar)[XB_TMO], 1u); break; } } } } while (0)
struct XcdBarrier { unsigned* bar; unsigned x; volatile LAS unsigned* st; };
__device__ __forceinline__ XcdBarrier xcd_barrier_post(unsigned* bar, volatile LAS unsigned* st) {
    XcdBarrier b; b.bar = bar; b.x = xb_xcc_id(); b.st = st;
    if (threadIdx.x == 0) (void)xb_add(&bar[XB_XCNT(b.x)], 1u);
    return b;
}
__device__ __forceinline__ void xcd_barrier_complete(unsigned* bar, unsigned x, unsigned& nloc, unsigned& nx) {
    const unsigned G = gridDim.x * gridDim.y * gridDim.z;
    unsigned sum, cnt, mine, sp = 0u;
    for (;;) {
        sum = 0u; cnt = 0u; mine = 0u;
#pragma unroll
        for (unsigned j = 0; j < 16; ++j) { const unsigned c = xb_ld(&bar[XB_XCNT(j)]); sum += c; cnt += (c > 0u) ? 1u : 0u; mine = (j == x) ? c : mine; }
        if (sum == G) break;
        __builtin_amdgcn_s_sleep(1);
        if ((++sp & 255u) == 0u) { if (xb_ld(&bar[XB_TMO])) break; if (sp > XB_SPIN_CAP) { atomicAdd(&bar[XB_TMO], 1u); break; } }
    }
    nloc = mine > 0u ? mine : 1u; nx = cnt > 0u ? cnt : 1u;
}
__device__ __forceinline__ void xcd_barrier(const XcdBarrier& b) {
    asm volatile("s_waitcnt vmcnt(0)" ::: "memory");
    __syncthreads();
    if (threadIdx.x == 0) {
        unsigned* bar = b.bar;
        __builtin_amdgcn_s_waitcnt(0);
        unsigned nloc = b.st[0], nx = b.st[1];
        if (nloc == 0u) { xcd_barrier_complete(bar, b.x, nloc, nx); b.st[0] = nloc; b.st[1] = nx; }
        const unsigned old = xb_add(&bar[XB_XSUB(b.x)], 1u);
        const unsigned gen = old / nloc;
        if (old + 1u == (gen + 1u) * nloc) {
            __builtin_amdgcn_fence(__ATOMIC_RELEASE, "agent");
            asm volatile("s_waitcnt vmcnt(0)" ::: "memory");
            const unsigned og = xb_add(&bar[XB_TOP], 1u);
            const unsigned tg = og / nx;
            if (og + 1u == (tg + 1u) * nx) xb_add(&bar[XB_TOPGEN], 1u);
            else XB_SPIN(xb_ld(&bar[XB_TOPGEN]) == tg, bar);
            __builtin_amdgcn_fence(__ATOMIC_ACQUIRE, "agent");
            xb_add(&bar[XB_XGEN(b.x)], 1u);
            asm volatile("s_waitcnt vmcnt(0)" ::: "memory");
        } else {
            XB_SPIN(xb_ld(&bar[XB_XGEN(b.x)]) == gen, bar);
            __builtin_amdgcn_fence(__ATOMIC_ACQUIRE, "agent");
            asm volatile("s_waitcnt vmcnt(0)" ::: "memory");
        }
    }
    __syncthreads();
}

__global__ void __launch_bounds__(NWAVES * 64, 2) hybrid_fwd(Params p) {
    extern __shared__ __attribute__((aligned(16))) unsigned char lds_raw[];
    LAS unsigned char* lds = (LAS unsigned char*)lds_raw;
    cg::grid_group grid = cg::this_grid();
    const int G = gridDim.x;
    unsigned char* ws = p.ws;
    bf16_t* xb = (bf16_t*)(ws + WS_XB); bf16_t* act = (bf16_t*)(ws + WS_ACT); bf16_t* cat = (bf16_t*)(ws + WS_CAT);
    float* ssq = (float*)(ws + WS_SSQ);
    LAS float* tbl = (LAS float*)(lds + TBL_OFF);

    volatile LAS unsigned* misc = (volatile LAS unsigned*)(lds + MISC_OFF);
    if (threadIdx.x < 2) misc[threadIdx.x] = 0u;
    __syncthreads();
    const XcdBarrier xbar = xcd_barrier_post((unsigned*)(ws + WS_CTL), misc);
    prologue_phase(p, lds, G);
    grid.sync();

    int np = 16;
    const float* base = p.x;
#pragma unroll 1
    for (int layer = 0; layer < DEPTH; ++layer) {
#pragma unroll 1
        for (int j = 0; j < 2; ++j) {
            const int mi = layer * 2 + j;
            {
                pg8::Gemm g{xb, (const bf16_t*)(ws + WS_WFFN_IN + mi * SZ_WFFN_IN), M, 2 * DFF, DM};
                pg8::StaticOrder S; S.init(M, 2 * DFF, G, obid());
                EpiSwiglu E{act, RsTable{ssq, np, tbl}};
                pg8::gemm_phase<EpiSwiglu>(lds, g, S, E);
            }
            xcd_barrier(xbar);
            {
                pg8::Gemm g{act, (const bf16_t*)(ws + WS_WFFN_OUT + mi * SZ_WFFN_OUT), M, DM, DFF};
                pg8::StaticOrder S; S.init(M, DM, G, obid());
                EpiResid E{base, xb, ssq, 0.5f};
                pg8::gemm_phase<EpiResid>(lds, g, S, E);
            }
            base = nullptr; np = 16;
            xcd_barrier(xbar);
            if (j == 0) {
                if ((layer & 1) == 0) {
                    const int e = layer >> 1;
                    {
                        pg8::Gemm g{xb, (const bf16_t*)(ws + WS_WMIX_IN + e * SZ_WMIX_IN), M, MIXIN, DM};
                        pg8::StaticOrder S; S.init(M, MIXIN, G, obid());
                        EpiMixIn E{act, (float*)(ws + WS_F), (float*)(ws + WS_QS), p.hgrn_lb, e, RsTable{ssq, np, tbl}};
                        pg8::gemm_phase<EpiMixIn>(lds, g, S, E);
                    }
                    xcd_barrier(xbar);
                    for (int it = obid(); it < 256; it += G) hgrn_mma<false>(p, it, lds);
                    attn_mma(p, e, lds, G);
                    xcd_barrier(xbar);
                    for (int it = obid(); it < 256; it += G) hgrn_mma<true>(p, it, lds);
                    xcd_barrier(xbar);
                    {
                        pg8::Gemm g{cat, (const bf16_t*)(ws + WS_WMIX_OUT + e * SZ_WMIX_OUT), M, DM, DM};
                        pg8::StaticOrder S; S.init(M, DM, G, obid());
                        EpiResid E{base, xb, ssq, 1.0f};
                        pg8::gemm_phase<EpiResid>(lds, g, S, E);
                    }
                    np = 16;
                    xcd_barrier(xbar);
                } else {
                    const int oi = layer >> 1;
                    s5_phase(p, layer, oi, lds, G);
                    xcd_barrier(xbar);
                    {
                        pg8::Gemm g{cat, (const bf16_t*)(ws + WS_WGLU + oi * SZ_WGLU), M, 2 * DM, DM};
                        pg8::StaticOrder S; S.init(M, 2 * DM, G, obid());
                        EpiGlu E{xb, ssq};
                        pg8::gemm_phase<EpiGlu>(lds, g, S, E);
                    }
                    np = 32;
                    xcd_barrier(xbar);
                }
            }
        }
    }
    final_norm(p, G);
}

extern "C" void kernel_launch(void* const* d_in, const int* in_sizes, int n_in, void* d_out, int out_size, void* d_ws, size_t ws_size, hipStream_t stream) {
    static int grid = 0;
    if (grid == 0) {
        if (n_in != 18 || in_sizes[0] != M * DM || out_size != M * DM || ws_size < WS_END) {
            fprintf(stderr, "kernel_launch: unexpected shapes: n_in %d in0 %d out %d ws %zu (need %zu)\n", n_in, n_in > 0 ? in_sizes[0] : -1, out_size, ws_size, (size_t)WS_END); grid = -1; return; }
        int dev = 0, cus = 0, per_cu = 0;
        hipGetDevice(&dev);
        hipDeviceGetAttribute(&cus, hipDeviceAttributeMultiprocessorCount, dev);
        if (hipFuncSetAttribute((const void*)hybrid_fwd, hipFuncAttributeMaxDynamicSharedMemorySize, LDS_BYTES) != hipSuccess) { fprintf(stderr, "kernel_launch: hipFuncSetAttribute failed\n"); grid = -1; return; }
        if (hipOccupancyMaxActiveBlocksPerMultiprocessor(&per_cu, (const void*)hybrid_fwd, NWAVES * 64, LDS_BYTES) != hipSuccess || per_cu < 1) { fprintf(stderr, "kernel_launch: occupancy query gave %d\n", per_cu); per_cu = 1; }
        (void)hipGetLastError();
        grid = cus * per_cu;
    }
    if (grid < 0) return;
    if (hipMemsetAsync((char*)d_ws + WS_CTL, 0, CTL_BYTES, stream) != hipSuccess) { fprintf(stderr, "kernel_launch: memset of barrier words failed\n"); return; }
    Params p{};
    const float** pp = (const float**)&p;
    for (int i = 0; i < 18; ++i) pp[i] = (const float*)d_in[i];
    p.out = (float*)d_out; p.ws = (unsigned char*)d_ws;
    void* args[] = {&p};
    hipError_t e = hipLaunchCooperativeKernel((const void*)hybrid_fwd, dim3(grid), dim3(NWAVES * 64), args, LDS_BYTES, stream);
    if (e != hipSuccess) fprintf(stderr, "cooperative launch failed: %s (grid %d)\n", hipGetErrorString(e), grid);
}
```
